# Optimizing an MI355X kernel written in HIP

```python
import jax, jax.numpy as jnp
from jax import lax
import numpy as np

D_MODEL = 2048
BATCH = 1
SEQ = 8192
DEPTH = 2

GRID_W = 64
HEAD_DIM = 128
D_MIX = D_MODEL
N_HEADS_NA = (D_MIX // 2) // HEAD_DIM
N_HEADS_Q = (D_MIX // 2) // HEAD_DIM
N_KV_HEADS = 2
D_NA = N_HEADS_NA * HEAD_DIM
D_GQA = N_HEADS_Q * HEAD_DIM
D_KV = N_KV_HEADS * HEAD_DIM
D_IN = 3 * D_NA + D_GQA + 2 * D_KV
NA_KH = 8
NA_KW = 16
Q_BLOCK = 128
ROPE_THETA = 10000.0
D_FF = 5632
RMS_EPS = 1e-6
LN_EPS = 1e-5
DEEPNORM_ALPHA = (2.0 * DEPTH) ** 0.25
DEEPNORM_BETA = (8.0 * DEPTH) ** -0.25

kernel_name = "hybrid_natten_gqa_macaron_deepnorm"


def layer_norm(x, g, b):
    xf = x.astype(jnp.float32)
    mu = jnp.mean(xf, axis=-1, keepdims=True)
    xc = xf - mu
    var = jnp.mean(xc * xc, axis=-1, keepdims=True)
    y = xc * lax.rsqrt(var + LN_EPS)
    return (y * g.astype(jnp.float32) + b.astype(jnp.float32)).astype(x.dtype)


def rms_norm(x, g):
    xf = x.astype(jnp.float32)
    y = xf * lax.rsqrt(jnp.mean(xf * xf, axis=-1, keepdims=True) + RMS_EPS)
    return (y * g.astype(jnp.float32)).astype(x.dtype)


def swiglu(x, w_gate_up, w_down):
    gate, up = jnp.split(x @ w_gate_up, 2, axis=-1)
    return (jax.nn.silu(gate) * up) @ w_down


def axial_rope(x):
    _, S, _, D = x.shape
    half = D // 2
    nfreq = half // 2
    t = jnp.arange(S)
    row = (t // GRID_W).astype(jnp.float32)
    col = (t % GRID_W).astype(jnp.float32)
    inv_freq = 1.0 / (ROPE_THETA ** (jnp.arange(nfreq, dtype=jnp.float32) / nfreq))

    def rot(xh, pos):
        ang = pos[:, None] * inv_freq[None, :]
        cos = jnp.cos(ang)[None, :, None, :]
        sin = jnp.sin(ang)[None, :, None, :]
        x1, x2 = xh[..., :nfreq], xh[..., nfreq:]
        return jnp.concatenate([x1 * cos - x2 * sin, x2 * cos + x1 * sin], axis=-1)

    xf = x.astype(jnp.float32)
    out = jnp.concatenate([rot(xf[..., :half], row), rot(xf[..., half:], col)], axis=-1)
    return out.astype(x.dtype)


def neighbourhood_attention(q, k, v, rel_bias):
    B, S, H, D = q.shape
    rows = S // GRID_W
    kh = min(NA_KH, rows)
    r = jnp.arange(rows)
    r0 = jnp.clip(r - kh // 2, 0, rows - kh)
    row_idx = r0[:, None] + jnp.arange(kh)[None, :]
    c = jnp.arange(GRID_W)
    c0 = jnp.clip(c - NA_KW // 2, 0, GRID_W - NA_KW)
    kc = jnp.arange(GRID_W)
    col_in = (kc[None, :] >= c0[:, None]) & (kc[None, :] < c0[:, None] + NA_KW)
    drow_idx = row_idx - r[:, None] + (NA_KH - 1)
    dcol_idx = jnp.clip(kc[None, :] - c[:, None], -(NA_KW - 1), NA_KW - 1) + (NA_KW - 1)
    bias = rel_bias[:, drow_idx[:, :, None, None], dcol_idx[None, None, :, :]]
    bias = jnp.transpose(bias, (0, 1, 3, 2, 4)).astype(jnp.float32)

    scale = HEAD_DIM ** -0.5
    qg = q.reshape(B, rows, GRID_W, H, D)
    kg = k.reshape(B, rows, GRID_W, H, D)[:, row_idx]
    vg = v.reshape(B, rows, GRID_W, H, D)[:, row_idx]
    s = jnp.einsum('brchd,brukhd->bhrcuk', qg, kg).astype(jnp.float32) * scale
    s = s + bias[None]
    s = jnp.where(col_in[None, None, None, :, None, :], s, -jnp.inf)
    sh = s.shape
    p = jax.nn.softmax(s.reshape(sh[:4] + (kh * GRID_W,)), axis=-1).reshape(sh)
    o = jnp.einsum('bhrcuk,brukhd->brchd', p.astype(v.dtype), vg)
    return o.reshape(B, S, H, D)


def gqa_block_attention(q, k, v):
    B, S, Hq, D = q.shape
    Hkv = k.shape[2]
    G = Hq // Hkv
    nblk = S // Q_BLOCK
    scale = HEAD_DIM ** -0.5
    qb = jnp.transpose(q.reshape(B, nblk, Q_BLOCK, Hkv, G, D), (1, 0, 2, 3, 4, 5))

    def one_block(qblk):
        s = jnp.einsum('bqhgd,bkhd->bhgqk', qblk, k).astype(jnp.float32) * scale
        p = jax.nn.softmax(s, axis=-1)
        return jnp.einsum('bhgqk,bkhd->bqhgd', p.astype(v.dtype), v)

    o = lax.map(one_block, qb)
    return jnp.transpose(o, (1, 0, 2, 3, 4, 5)).reshape(B, S, Hq * D)


def setup_inputs(seed: int = 0) -> dict:
    key = jax.random.key(seed)
    ks = jax.random.split(key, 20)
    f32 = jnp.float32

    def nrm(k, shape, scale):
        return jax.random.normal(k, shape, f32) * scale

    def gain(k, shape):
        return 1.0 + 0.05 * jax.random.normal(k, shape, f32)

    return {
        "x": jax.random.normal(ks[0], (BATCH, SEQ, D_MODEL), f32),
        "ffn1_w_gate_up": nrm(ks[1], (DEPTH, D_MODEL, 2 * D_FF), D_MODEL ** -0.5),
        "ffn1_w_down": nrm(ks[2], (DEPTH, D_FF, D_MODEL), DEEPNORM_BETA * D_FF ** -0.5),
        "ln1_g": gain(ks[3], (DEPTH, D_MODEL)),
        "ln1_b": nrm(ks[4], (DEPTH, D_MODEL), 0.02),
        "w_in": nrm(ks[5], (DEPTH, D_MODEL, D_IN), D_MODEL ** -0.5),
        "na_rel_bias": nrm(ks[6], (DEPTH, N_HEADS_NA, 2 * NA_KH - 1, 2 * NA_KW - 1), 0.1),
        "q_norm_g": gain(ks[7], (DEPTH, HEAD_DIM)),
        "k_norm_g": gain(ks[8], (DEPTH, HEAD_DIM)),
        "gn_na_g": gain(ks[9], (DEPTH, D_NA)),
        "gn_gqa_g": gain(ks[10], (DEPTH, D_GQA)),
        "w_out": nrm(ks[11], (DEPTH, D_MIX, D_MODEL), DEEPNORM_BETA * D_MIX ** -0.5),
        "ln2_g": gain(ks[12], (DEPTH, D_MODEL)),
        "ln2_b": nrm(ks[13], (DEPTH, D_MODEL), 0.02),
        "ffn2_w_gate_up": nrm(ks[14], (DEPTH, D_MODEL, 2 * D_FF), D_MODEL ** -0.5),
        "ffn2_w_down": nrm(ks[15], (DEPTH, D_FF, D_MODEL), DEEPNORM_BETA * D_FF ** -0.5),
        "ln3_g": gain(ks[16], (DEPTH, D_MODEL)),
        "ln3_b": nrm(ks[17], (DEPTH, D_MODEL), 0.02),
    }


def reference(x, ffn1_w_gate_up, ffn1_w_down, ln1_g, ln1_b, w_in, na_rel_bias,
              q_norm_g, k_norm_g, gn_na_g, gn_gqa_g, w_out, ln2_g, ln2_b,
              ffn2_w_gate_up, ffn2_w_down, ln3_g, ln3_b):
    B, S, _ = x.shape
    for l in range(DEPTH):
        x = layer_norm(DEEPNORM_ALPHA * x + 0.5 * swiglu(x, ffn1_w_gate_up[l], ffn1_w_down[l]),
                       ln1_g[l], ln1_b[l])

        h = x @ w_in[l]
        q_na, k_na, v_na, q_g, k_g, v_g = jnp.split(
            h, np.cumsum([D_NA, D_NA, D_NA, D_GQA, D_KV]).tolist(), axis=-1)

        o_na = neighbourhood_attention(
            q_na.reshape(B, S, N_HEADS_NA, HEAD_DIM),
            k_na.reshape(B, S, N_HEADS_NA, HEAD_DIM),
            v_na.reshape(B, S, N_HEADS_NA, HEAD_DIM),
            na_rel_bias[l]).reshape(B, S, D_NA)

        qh = axial_rope(rms_norm(q_g.reshape(B, S, N_HEADS_Q, HEAD_DIM), q_norm_g[l]))
        kh = axial_rope(rms_norm(k_g.reshape(B, S, N_KV_HEADS, HEAD_DIM), k_norm_g[l]))
        vh = v_g.reshape(B, S, N_KV_HEADS, HEAD_DIM)
        o_g = gqa_block_attention(qh, kh, vh)

        mix = jnp.concatenate([rms_norm(o_na, gn_na_g[l]), rms_norm(o_g, gn_gqa_g[l])], axis=-1) @ w_out[l]
        x = layer_norm(DEEPNORM_ALPHA * x + mix, ln2_g[l], ln2_b[l])

        x = layer_norm(DEEPNORM_ALPHA * x + 0.5 * swiglu(x, ffn2_w_gate_up[l], ffn2_w_down[l]),
                       ln3_g[l], ln3_b[l])
    return x
```

```cpp
#include <hip/hip_runtime.h>
#include <hip/hip_cooperative_groups.h>
#include <hip/hip_bf16.h>
#include <cstdio>
#include <cstdint>
namespace cg = cooperative_groups;
namespace pg8 {
#define PG8_LAS __attribute__((address_space(3)))
typedef unsigned short bf16_t;
typedef short bf16x8 __attribute__((ext_vector_type(8)));
typedef float f32x4 __attribute__((ext_vector_type(4)));
typedef unsigned u32x4 __attribute__((ext_vector_type(4)));
constexpr int BM = 256, BK = 64, HALF = 128, HTB = HALF * BK * 2  , STAGE_BYTES = 8 * HTB, NXCD = 8, WGM = 4;

__host__ __device__ __forceinline__ int lds_byte(int r, int c) { const int st = (r >> 4) * 2 + (c >> 5), rr = r & 15, cc = c & 31, ob = rr * 64 + cc * 2; return st * 1024 + (ob ^ (((ob >> 9) & 1) << 5)); }
__host__ __device__ __forceinline__ void stage_rc(int b, int& R, int& C) { const int st = b / 1024, sb = b % 1024, swz = sb ^ (((sb >> 9) & 1) << 5); R = (st >> 1) * 16 + swz / 64; C = (st & 1) * 32 + (swz % 64) / 2; }
__host__ __device__ __forceinline__ int perm32(int rho) { const int n = rho >> 4, i = rho & 15; return 8 * (i >> 2) + 4 * n + (i & 3); }

struct Unit { int pm, pn, ah, bh, mk; };
struct Gemm { const bf16_t* A; const bf16_t* Bt; int M, N, K; };

struct StaticOrder {
    int nM, nN, nwg, G, c;
    __host__ __device__ void init(int M, int N, int G_, int c_) { nM = M / BM; nN = N / BM; nwg = nM * nN; G = G_; c = c_; }
    __host__ __device__ bool next(int i, Unit& u) const {
        const long L = (long)i * G + c; if (L >= nwg) return false;
        int wgid = (int)L; { const int q = nwg / NXCD, r = nwg % NXCD, xcd = wgid % NXCD, off = wgid / NXCD; wgid = (xcd < r ? xcd * (q + 1) : r * (q + 1) + (xcd - r) * q) + off; }
        const int nig = WGM * nN, gid = wgid / nig, fm = gid * WGM, gsz = (nM - fm) < WGM ? (nM - fm) : WGM;
        u.pm = fm + ((wgid % nig) % gsz); u.pn = (wgid % nig) / gsz; u.ah = 0; u.bh = 0; u.mk = 15; return true;
    }
    __device__ __forceinline__ void a_ready(const Unit&) const {}
    __device__ __forceinline__ void done(const Unit&) const {}
};
struct TailOrder {
    int nM, nN, nwg, G, c, nfull, rem, S;
    __host__ __device__ void init(int M, int N, int G_, int c_, int maxS) { nM = M / BM; nN = N / BM; nwg = nM * nN; G = G_; c = c_; nfull = (nwg / G) * G; rem = nwg - nfull; S = 1;
        if (rem > 0) { const int q = G / rem; S = q >= 4 ? 4 : (q >= 2 ? 2 : 1); if (S > maxS) S = maxS; } }
    __host__ __device__ bool next(int i, Unit& u) const {
        const long L = (long)i * G + c; int wgid, part = 0;
        if (L < nfull) wgid = (int)L; else { const int sidx = (int)(L - nfull); if (sidx >= rem * S) return false; wgid = nfull + sidx % rem; part = sidx / rem; }
        const bool sub = (L >= nfull) && S > 1;
        { const int q = nwg / NXCD, r = nwg % NXCD, xcd = wgid % NXCD, off = wgid / NXCD; wgid = (xcd < r ? xcd * (q + 1) : r * (q + 1) + (xcd - r) * q) + off; }
        const int nig = WGM * nN, gid = wgid / nig, fm = gid * WGM, gsz = (nM - fm) < WGM ? (nM - fm) : WGM;
        u.pm = fm + ((wgid % nig) % gsz); u.pn = (wgid % nig) / gsz;
        if (!sub) { u.ah = 0; u.bh = 0; u.mk = 15; } else if (S == 2) { u.ah = part; u.bh = 0; u.mk = 3; } else { u.ah = part & 1; u.bh = part >> 1; u.mk = 1; }
        return true;
    }
    __device__ __forceinline__ void a_ready(const Unit&) const {}
    __device__ __forceinline__ void done(const Unit&) const {}
};

__device__ __forceinline__ void store16_wt(void* p, u32x4 v) { asm volatile("global_store_dwordx4 %0, %1, off sc0 sc1\n\ts_nop 1" :: "v"(p), "v"(v) : "memory"); }
__device__ __forceinline__ unsigned cvt_pk_bf16(float lo, float hi) { unsigned r; asm volatile("v_cvt_pk_bf16_f32 %0, %1, %2" : "=v"(r) : "v"(lo), "v"(hi)); return r; }
typedef float f32x2 __attribute__((ext_vector_type(2)));
__device__ __forceinline__ f32x2 gelu_pk(f32x2 v) {
    const f32x2 av = __builtin_elementwise_abs(v), d = av * 0.2316418882f + 1.0f;
    f32x2 t; t.x = __builtin_amdgcn_rcpf(d.x); t.y = __builtin_amdgcn_rcpf(d.y);
    f32x2 q = t * 0.5307027145f + (-0.7265760135f); q = q * t + 0.7107068705f; q = q * t + (-0.142248368f); q = q * t + 0.127414796f; q = q * t;
    const f32x2 s = (v * v) * (-0.72134752044f);
    f32x2 e; e.x = __builtin_amdgcn_exp2f(s.x); e.y = __builtin_amdgcn_exp2f(s.y);
    const f32x2 m = v * (q * e), r = v - m;
    f32x2 o; o.x = v.x < 0.f ? m.x : r.x; o.y = v.y < 0.f ? m.y : r.y; return o;
}

template <int ACT  > struct EpiBf16 {
    static constexpr bool PERM = true, AFTER_DRAIN = false, MID = false; static_assert(ACT == 0 || ACT == 1, "EpiBf16: ACT is 0 (none) or 1 (gelu_pk)");
    bf16_t* O; int ldc; const float* bias; int split_cols; size_t split_stride; float scale0;
    __device__ __forceinline__ void operator()(const f32x4 (&acc)[2][2][4][2], const Unit& u, int wr, int wc, int fr, int fq) const {
        const int row0 = u.pm * BM + u.ah * HALF + wr * 64 + fr; int colt = u.pn * BM + u.bh * HALF; bf16_t* base = O;
        float sc = 1.f; if (split_cols) { const int t = colt / split_cols; base += (size_t)t * split_stride; colt -= t * split_cols; if (t == 0) sc = scale0; }
        const int col0 = colt + wc * 32 + 8 * fq, bcol0 = u.pn * BM + wc * 32 + 8 * fq;
        f32x4 bv[2][2];
#pragma unroll
        for (int bj = 0; bj < 2; ++bj)
#pragma unroll
            for (int n = 0; n < 2; ++n) bv[bj][n] = bias ? *(const f32x4*)(bias + bcol0 + bj * HALF + 4 * n) : (f32x4){0.f, 0.f, 0.f, 0.f};
#pragma unroll
        for (int ai = 0; ai < 2; ++ai)
#pragma unroll
            for (int m = 0; m < 4; ++m) { bf16_t* rowp = base + (size_t)(row0 + ai * HALF + m * 16) * ldc + col0;
#pragma unroll
                for (int bj = 0; bj < 2; ++bj) { if (!((u.mk >> (2 * ai + bj)) & 1)) continue; f32x4 v0 = acc[ai][bj][m][0] + bv[bj][0], v1 = acc[ai][bj][m][1] + bv[bj][1];
                    if (ACT == 1) { f32x2 a = gelu_pk((f32x2){v0[0], v0[1]}), b = gelu_pk((f32x2){v0[2], v0[3]}), c = gelu_pk((f32x2){v1[0], v1[1]}), d = gelu_pk((f32x2){v1[2], v1[3]});
                        v0 = (f32x4){a.x, a.y, b.x, b.y}; v1 = (f32x4){c.x, c.y, d.x, d.y}; }
                    v0 = v0 * sc; v1 = v1 * sc; u32x4 w; w.x = cvt_pk_bf16(v0[0], v0[1]); w.y = cvt_pk_bf16(v0[2], v0[3]); w.z = cvt_pk_bf16(v1[0], v1[1]); w.w = cvt_pk_bf16(v1[2], v1[3]);
                    *(u32x4*)(rowp + bj * HALF) = w; } }
    }
};
struct EpiSwiGLU {
    static constexpr bool PERM = true, AFTER_DRAIN = false, MID = false;
    bf16_t* O; int ldc;
    __device__ __forceinline__ void operator()(const f32x4 (&acc)[2][2][4][2], const Unit& u, int wr, int wc, int fr, int fq) const {
        const int row0 = u.pm * BM + u.ah * HALF + wr * 64 + fr; const int col0 = u.pn * HALF + wc * 32 + 8 * fq;
#pragma unroll
        for (int ai = 0; ai < 2; ++ai)
#pragma unroll
            for (int m = 0; m < 4; ++m) { if (!((u.mk >> (2 * ai)) & 1)) continue; bf16_t* rowp = O + (size_t)(row0 + ai * HALF + m * 16) * ldc + col0;
                float h[8];
#pragma unroll
                for (int n = 0; n < 2; ++n)
#pragma unroll
                    for (int e = 0; e < 4; ++e) { const float g = acc[ai][0][m][n][e], up = acc[ai][1][m][n][e];
                        const float s = __builtin_amdgcn_rcpf(1.0f + __builtin_amdgcn_exp2f(-1.4426950408889634f * g));
                        h[n * 4 + e] = g * s * up; }
                u32x4 w; w.x = cvt_pk_bf16(h[0], h[1]); w.y = cvt_pk_bf16(h[2], h[3]); w.z = cvt_pk_bf16(h[4], h[5]); w.w = cvt_pk_bf16(h[6], h[7]);
                *(u32x4*)rowp = w; }
    }
};
struct EpiResid {
    static constexpr bool PERM = false, AFTER_DRAIN = false, MID = false;
    const float* base; float* out; int ldc; float sa, sb;
    __device__ __forceinline__ void operator()(const f32x4 (&acc)[2][2][4][2], const Unit& u, int wr, int wc, int fr, int fq) const {
        const int col0 = u.pn * BM + wc * 32 + 4 * fq;
#pragma unroll
        for (int ai = 0; ai < 2; ++ai)
#pragma unroll
            for (int m = 0; m < 4; ++m) { const size_t off = (size_t)(u.pm * BM + ai * HALF + wr * 64 + m * 16 + fr) * ldc + col0;
#pragma unroll
                for (int bj = 0; bj < 2; ++bj)
#pragma unroll
                    for (int n = 0; n < 2; ++n) { const f32x4 bs = *(const f32x4*)(base + off + bj * HALF + n * 16);
                        *(f32x4*)(out + off + bj * HALF + n * 16) = bs * sa + acc[ai][bj][m][n] * sb; } }
    }
};
__device__ __forceinline__ float xshfl(float v, int o, int lane) { return __int_as_float(__builtin_amdgcn_ds_bpermute((lane ^ o) << 2, __float_as_int(v))); }
struct PanelStats8 {
    unsigned long long* xbuf;
    unsigned* cnt;
    float eps;
    __device__ __forceinline__ void run(const f32x4 (&v)[2][2][4][2], const Unit& u, int wr, int wc, int fr, int fq, PG8_LAS unsigned char* lds, int wid, int lane) const {
        typedef float f32x2v __attribute__((ext_vector_type(2)));
        PG8_LAS f32x2v* P = (PG8_LAS f32x2v*)lds;
        PG8_LAS f32x2v* S = (PG8_LAS f32x2v*)(lds + 8192);
#pragma unroll
        for (int ai = 0; ai < 2; ++ai)
#pragma unroll
            for (int m = 0; m < 4; ++m) {
                float s = 0.f;
#pragma unroll
                for (int bj = 0; bj < 2; ++bj)
#pragma unroll
                    for (int n = 0; n < 2; ++n) { const f32x4 x = v[ai][bj][m][n]; s += (x[0] + x[1]) + (x[2] + x[3]); }
                s += xshfl(s, 16, lane); s += xshfl(s, 32, lane);
                const float mw = s * (1.0f / 64.0f); float q = 0.f;
#pragma unroll
                for (int bj = 0; bj < 2; ++bj)
#pragma unroll
                    for (int n = 0; n < 2; ++n) { const f32x4 d = v[ai][bj][m][n] - mw; q += (d[0] * d[0] + d[1] * d[1]) + (d[2] * d[2] + d[3] * d[3]); }
                q += xshfl(q, 16, lane); q += xshfl(q, 32, lane);
                if (fq == 0) P[(ai * HALF + wr * 64 + m * 16 + fr) * 4 + wc] = (f32x2v){mw, q};
            }
        asm volatile("s_waitcnt lgkmcnt(0)" ::: "memory"); __builtin_amdgcn_s_barrier(); asm volatile("" ::: "memory");
        const int row = wid * 32 + (lane & 31);
        if (lane < 32) {
            const f32x2v a = P[row * 4 + 0], b = P[row * 4 + 1], c = P[row * 4 + 2], d = P[row * 4 + 3];
            const float mt = (a.x + b.x + c.x + d.x) * 0.25f;
            const float da = a.x - mt, db = b.x - mt, dc = c.x - mt, dd = d.x - mt;
            const float m2 = (a.y + b.y) + (c.y + d.y) + 64.0f * ((da * da + db * db) + (dc * dc + dd * dd));
            unsigned long long* slot = xbuf + ((size_t)(u.pm * BM + row) * 8 + u.pn);
            __hip_atomic_store(slot, ((unsigned long long)__float_as_uint(m2) << 32) | __float_as_uint(mt), __ATOMIC_RELAXED, __HIP_MEMORY_SCOPE_AGENT);
        }
        asm volatile("s_waitcnt vmcnt(0)" ::: "memory");
        if (lane == 0) __hip_atomic_fetch_add(cnt + 64 * u.pm, 1u, __ATOMIC_RELAXED, __HIP_MEMORY_SCOPE_AGENT);
        if (wid == 0) {
            unsigned sp = 0;
            for (;;) {
                if ((unsigned)__builtin_amdgcn_readfirstlane(__hip_atomic_load(cnt + 64 * u.pm, __ATOMIC_RELAXED, __HIP_MEMORY_SCOPE_AGENT)) >= 64u) break;
                if (++sp > (1u << 22)) break;
                __builtin_amdgcn_s_sleep(2);
            }
            __builtin_amdgcn_fence(__ATOMIC_ACQUIRE, "agent");
        }
        asm volatile("s_waitcnt vmcnt(0) lgkmcnt(0)" ::: "memory"); __builtin_amdgcn_s_barrier(); asm volatile("" ::: "memory");
        if (lane < 32) {
            const unsigned long long* slot = xbuf + (size_t)(u.pm * BM + row) * 8; float mt[8], m2[8]; float ms = 0.f;
#pragma unroll
            for (int t = 0; t < 8; ++t) { const unsigned long long w = __hip_atomic_load(slot + t, __ATOMIC_RELAXED, __HIP_MEMORY_SCOPE_AGENT); mt[t] = __uint_as_float((unsigned)w); m2[t] = __uint_as_float((unsigned)(w >> 32)); ms += mt[t]; }
            const float mean = ms * 0.125f; float q = 0.f;
#pragma unroll
            for (int t = 0; t < 8; ++t) { const float dm = mt[t] - mean; q += m2[t] + 256.0f * dm * dm; }
            S[row] = (f32x2v){mean, 1.0f / sqrtf(q * (1.0f / 2048.0f) + eps)};
        }
        asm volatile("s_waitcnt lgkmcnt(0)" ::: "memory"); __builtin_amdgcn_s_barrier(); asm volatile("" ::: "memory");
    }
};
struct EpiResidLn {
    static constexpr bool PERM = true, AFTER_DRAIN = true, MID = true;
    const bf16_t* base; float* out; bf16_t* outb; int ldc; float sa, sb; const float* g; const float* b; PanelStats8 st; const PG8_LAS float* rs; int use_rs;
    __device__ __forceinline__ void mid(f32x4 (&acc)[2][2][4][2], const Unit& u, int wr, int fr) const {
        const PG8_LAS float* rp = rs + 2 * (wr * 64 + fr);
#pragma unroll
        for (int ai = 0; ai < 2; ++ai)
#pragma unroll
            for (int m = 0; m < 4; ++m) { const float r = rp[2 * (ai * HALF + m * 16)];
#pragma unroll
                for (int bj = 0; bj < 2; ++bj)
#pragma unroll
                    for (int n = 0; n < 2; ++n) acc[ai][bj][m][n] *= r; }
    }
    __device__ __forceinline__ void operator()(const f32x4 (&)[2][2][4][2], const Unit&, int, int, int, int) const {}
    __device__ __forceinline__ void fused(f32x4 (&acc)[2][2][4][2], const Unit& u, int wr, int wc, int fr, int fq, PG8_LAS unsigned char* lds, int wid, int lane) const {
        typedef float f32x2v __attribute__((ext_vector_type(2)));
        const PG8_LAS f32x2v* S = (const PG8_LAS f32x2v*)(lds + 8192);
        const int col0 = u.pn * BM + wc * 32 + 8 * fq;
        u32x4 bw[2][4][2];
#pragma unroll
        for (int ai = 0; ai < 2; ++ai)
#pragma unroll
            for (int m = 0; m < 4; ++m) { const size_t off = (size_t)(u.pm * BM + ai * HALF + wr * 64 + m * 16 + fr) * ldc + col0;
#pragma unroll
                for (int bj = 0; bj < 2; ++bj) bw[ai][m][bj] = *(const u32x4*)(base + off + bj * HALF); }
#pragma unroll
        for (int ai = 0; ai < 2; ++ai)
#pragma unroll
            for (int m = 0; m < 4; ++m) {
                float sbr = 0.5f; if (use_rs) sbr = rs[2 * (wr * 64 + fr) + 2 * (ai * HALF + m * 16) + 1];
#pragma unroll
                for (int bj = 0; bj < 2; ++bj)
#pragma unroll
                    for (int n = 0; n < 2; ++n) { const unsigned w0 = bw[ai][m][bj][2 * n], w1 = bw[ai][m][bj][2 * n + 1];
                        const f32x4 bs = {__uint_as_float(w0 << 16), __uint_as_float(w0 & 0xffff0000u), __uint_as_float(w1 << 16), __uint_as_float(w1 & 0xffff0000u)};
                        acc[ai][bj][m][n] = bs * 1.4142135623730951f + acc[ai][bj][m][n] * sbr; } }
        st.run(acc, u, wr, wc, fr, fq, lds, wid, lane);
        f32x4 gv[2][2], bv[2][2];
#pragma unroll
        for (int bj = 0; bj < 2; ++bj)
#pragma unroll
            for (int n = 0; n < 2; ++n) { gv[bj][n] = *(const f32x4*)(g + col0 + bj * HALF + n * 4); bv[bj][n] = *(const f32x4*)(b + col0 + bj * HALF + n * 4); }
#pragma unroll
        for (int ai = 0; ai < 2; ++ai)
#pragma unroll
            for (int m = 0; m < 4; ++m) { const int r = ai * HALF + wr * 64 + m * 16 + fr; const f32x2v sr = S[r]; const size_t off = (size_t)(u.pm * BM + r) * ldc + col0;
#pragma unroll
                for (int bj = 0; bj < 2; ++bj) {
                    const f32x4 o0 = (acc[ai][bj][m][0] - sr.x) * sr.y * gv[bj][0] + bv[bj][0], o1 = (acc[ai][bj][m][1] - sr.x) * sr.y * gv[bj][1] + bv[bj][1];
                    if (out) { *(f32x4*)(out + off + bj * HALF) = o0; *(f32x4*)(out + off + bj * HALF + 4) = o1; }
                    else { u32x4 w; w.x = cvt_pk_bf16(o0[0], o0[1]); w.y = cvt_pk_bf16(o0[2], o0[3]); w.z = cvt_pk_bf16(o1[0], o1[1]); w.w = cvt_pk_bf16(o1[2], o1[3]); store16_wt(outb + off + bj * HALF, w); } }
            }
    }
};
template <class Epi, class Sched, bool ALIGN_EPI = false, bool SP2 = false>
__device__ __forceinline__ void gemm_phase(PG8_LAS unsigned char* lds, const Gemm g, const Sched& S, const Epi& E, const int tid) {
    const int wid = __builtin_amdgcn_readfirstlane(tid >> 6), lane = tid & 63, wr = wid >> 2, wc = wid & 3, fr = lane & 15, fq = lane >> 4;
    const int K = g.K, nt = K / BK;
    unsigned voffA[2], voffB[2];
#pragma unroll
    for (int i = 0; i < 2; ++i) { int R, C; stage_rc(tid * 16 + i * 8192, R, C); const int Rb = Epi::PERM ? ((R & ~31) + perm32(R & 31)) : R;
        voffA[i] = (unsigned)(R * K + C) * 2u; voffB[i] = (unsigned)(Rb * K + C) * 2u; }
    const size_t kstep = (size_t)(BK * 2);
    const size_t hstep = (size_t)HALF * K * 2;
    const size_t tstep = 2 * hstep;
    const unsigned ldsw = (unsigned)wid * 1024u;
    const int aoff = lds_byte(wr * 64 + fr, fq * 8), boff = lds_byte(wc * 32 + fr, fq * 8);
#define PG8_SA(b, h) (((b) * 2 + (h)) * HTB)
#define PG8_SB(b, h) ((4 + (b) * 2 + (h)) * HTB)
#define PG8_STAGE(bufoff, gbase, voff) do { _Pragma("unroll") for (int _i = 0; _i < 2; ++_i) \
        __builtin_amdgcn_global_load_lds((const unsigned*)((const char*)(gbase) + (voff)[_i]), (PG8_LAS unsigned*)(lds + (bufoff) + ldsw + _i * 8192), 16, 0, 0); } while (0)
#define PG8_LDA(dst, b, h) do { if (PG8_MSK && !(mk & (3 << (2 * (h))))) break; _Pragma("unroll") for (int m = 0; m < 4; ++m) _Pragma("unroll") for (int k = 0; k < 2; ++k) dst[m][k] = *(const PG8_LAS bf16x8*)(lds + PG8_SA(b, h) + aoff + m * 2048 + k * 1024); } while (0)
#define PG8_LDB(dst, b, h) do { if (PG8_MSK && !(mk & (5 << (h)))) break; _Pragma("unroll") for (int n = 0; n < 2; ++n) _Pragma("unroll") for (int k = 0; k < 2; ++k) dst[n][k] = *(const PG8_LAS bf16x8*)(lds + PG8_SB(b, h) + boff + n * 2048 + k * 1024); } while (0)
#define PG8_MMA(ai, bj, At, Bt) do { if (PG8_MSK && !((mk >> (2 * (ai) + (bj))) & 1)) break; __builtin_amdgcn_s_setprio(1); _Pragma("unroll") for (int m = 0; m < 4; ++m) _Pragma("unroll") for (int n = 0; n < 2; ++n) _Pragma("unroll") for (int k = 0; k < 2; ++k) \
        acc[ai][bj][m][n] = __builtin_amdgcn_mfma_f32_16x16x32_bf16(Bt[n][k], At[m][k], acc[ai][bj][m][n], 0, 0, 0); __builtin_amdgcn_s_setprio(0); } while (0)
#define PG8_WAIT_V(n) asm volatile("s_waitcnt vmcnt(" #n ")" ::: "memory")
#define PG8_WAIT_L(n) asm volatile("s_waitcnt lgkmcnt(" #n ")" ::: "memory")
#define PG8_BAR __builtin_amdgcn_s_barrier()
#define PG8_SCHED __builtin_amdgcn_sched_barrier(0)
    Unit cur, nxt; int ui = 0;
    if (!S.next(0, cur)) return;
    f32x4 acc[2][2][4][2];
#pragma unroll
    for (int a = 0; a < 2; ++a)
#pragma unroll
        for (int b = 0; b < 2; ++b)
#pragma unroll
            for (int m = 0; m < 4; ++m)
#pragma unroll
                for (int n = 0; n < 2; ++n) acc[a][b][m][n] = (f32x4){0.f, 0.f, 0.f, 0.f};
    bf16x8 At[4][2], B0[2][2], B1[2][2];
    const char* cA = (const char*)g.A + (size_t)cur.pm * tstep + (size_t)cur.ah * hstep; const char* cB = (const char*)g.Bt + (size_t)cur.pn * tstep + (size_t)cur.bh * hstep;
    S.a_ready(cur);
    if constexpr (SP2) {
        PG8_STAGE(PG8_SB(0, 0), cB, voffB); PG8_STAGE(PG8_SB(0, 1), cB + hstep, voffB); PG8_STAGE(PG8_SA(0, 0), cA, voffA); PG8_STAGE(PG8_SA(0, 1), cA + hstep, voffA);
        if (wr == 1) PG8_BAR;
        PG8_WAIT_V(2); PG8_BAR;
        PG8_STAGE(PG8_SB(1, 0), cB + kstep, voffB); PG8_STAGE(PG8_SA(1, 0), cA + kstep, voffA); PG8_STAGE(PG8_SB(1, 1), cB + hstep + kstep, voffB);
        PG8_WAIT_V(6); PG8_BAR;
    } else {
        PG8_STAGE(PG8_SB(0, 0), cB, voffB); PG8_STAGE(PG8_SA(0, 0), cA, voffA); PG8_STAGE(PG8_SB(0, 1), cB + hstep, voffB); PG8_STAGE(PG8_SA(0, 1), cA + hstep, voffA);
        if (wr == 1) PG8_BAR;
        PG8_WAIT_V(4); PG8_BAR;
        PG8_STAGE(PG8_SB(1, 0), cB + kstep, voffB); PG8_STAGE(PG8_SA(1, 0), cA + kstep, voffA); PG8_STAGE(PG8_SB(1, 1), cB + hstep + kstep, voffB);
        PG8_WAIT_V(6); PG8_BAR;
    }
    for (;;) {
        const bool has_next = S.next(ui + 1, nxt);
        const char* nA = has_next ? (const char*)g.A + (size_t)nxt.pm * tstep + (size_t)nxt.ah * hstep : cA; const char* nB = has_next ? (const char*)g.Bt + (size_t)nxt.pn * tstep + (size_t)nxt.bh * hstep : cB;
        const int mk = cur.mk;
        if (mk == 15) {
#define PG8_MSK 0
        for (int t = 0; t < nt; t += 2) {
            const bool last = (t == nt - 2);
            if constexpr (Epi::MID) { if (E.use_rs && t == (nt >> 1)) E.mid(acc, cur, wr, fr); }
            const char* a1 = cA + (size_t)(t + 1) * kstep;
            const char* a2 = last ? nA : cA + (size_t)(t + 2) * kstep; const char* b2 = last ? nB : cB + (size_t)(t + 2) * kstep;
            const char* a3 = a2 + kstep; const char* b3 = b2 + kstep;
            if (last && has_next) S.a_ready(nxt);
            if constexpr (SP2) {
            PG8_LDB(B0, 0, 0); PG8_LDB(B1, 0, 1); PG8_SCHED; PG8_LDA(At, 0, 0); PG8_STAGE(PG8_SA(1, 1), a1 + hstep, voffA);
            PG8_WAIT_V(8); PG8_WAIT_L(0); PG8_BAR; PG8_MMA(0, 0, At, B0); PG8_MMA(0, 1, At, B1); PG8_BAR; PG8_SCHED;
            PG8_LDA(At, 0, 1); PG8_STAGE(PG8_SB(0, 0), b2, voffB); PG8_STAGE(PG8_SB(0, 1), b2 + hstep, voffB); PG8_STAGE(PG8_SA(0, 0), a2, voffA);
            PG8_WAIT_V(8); PG8_WAIT_L(0); PG8_BAR; PG8_MMA(1, 0, At, B0); PG8_MMA(1, 1, At, B1); PG8_BAR; PG8_SCHED;
            PG8_LDB(B0, 1, 0); PG8_LDB(B1, 1, 1); PG8_SCHED; PG8_LDA(At, 1, 0); PG8_STAGE(PG8_SA(0, 1), a2 + hstep, voffA);
            PG8_WAIT_V(8); PG8_WAIT_L(0); PG8_BAR; PG8_MMA(0, 0, At, B0); PG8_MMA(0, 1, At, B1); PG8_BAR; PG8_SCHED;
            PG8_LDA(At, 1, 1); PG8_STAGE(PG8_SB(1, 0), b3, voffB); PG8_STAGE(PG8_SB(1, 1), b3 + hstep, voffB); PG8_STAGE(PG8_SA(1, 0), a3, voffA);
            PG8_WAIT_V(8); PG8_WAIT_L(0); PG8_BAR; PG8_MMA(1, 0, At, B0); PG8_MMA(1, 1, At, B1); PG8_BAR; PG8_SCHED;
            } else {
            PG8_LDB(B0, 0, 0); PG8_SCHED; PG8_LDA(At, 0, 0); PG8_STAGE(PG8_SA(1, 1), a1 + hstep, voffA);
            PG8_WAIT_L(8); PG8_BAR; PG8_WAIT_L(0); PG8_MMA(0, 0, At, B0); PG8_BAR; PG8_SCHED;
            PG8_LDB(B1, 0, 1); PG8_STAGE(PG8_SB(0, 0), b2, voffB);
            PG8_BAR; PG8_WAIT_L(0); PG8_MMA(0, 1, At, B1); PG8_BAR;
            PG8_LDA(At, 0, 1); PG8_STAGE(PG8_SA(0, 0), a2, voffA);
            PG8_BAR; PG8_WAIT_L(0); PG8_MMA(1, 0, At, B0); PG8_BAR; PG8_SCHED;
            PG8_STAGE(PG8_SB(0, 1), b2 + hstep, voffB);
            PG8_WAIT_V(6); PG8_BAR; PG8_MMA(1, 1, At, B1); PG8_BAR;
            PG8_LDB(B0, 1, 0); PG8_SCHED; PG8_LDA(At, 1, 0); PG8_STAGE(PG8_SA(0, 1), a2 + hstep, voffA);
            PG8_WAIT_L(8); PG8_BAR; PG8_WAIT_L(0); PG8_MMA(0, 0, At, B0); PG8_BAR; PG8_SCHED;
            PG8_LDB(B1, 1, 1); PG8_STAGE(PG8_SB(1, 0), b3, voffB);
            PG8_BAR; PG8_WAIT_L(0); PG8_MMA(0, 1, At, B1); PG8_BAR;
            PG8_LDA(At, 1, 1); PG8_STAGE(PG8_SA(1, 0), a3, voffA);
            PG8_BAR; PG8_WAIT_L(0); PG8_MMA(1, 0, At, B0); PG8_BAR; PG8_SCHED;
            PG8_STAGE(PG8_SB(1, 1), b3 + hstep, voffB);
            PG8_WAIT_V(6); PG8_BAR; PG8_MMA(1, 1, At, B1); PG8_BAR;
            }
        }
#undef PG8_MSK
        } else {
#define PG8_MSK 1
        for (int t = 0; t < nt; t += 2) {
            const bool last = (t == nt - 2);
            if constexpr (Epi::MID) { if (E.use_rs && t == (nt >> 1)) E.mid(acc, cur, wr, fr); }
            const char* a1 = cA + (size_t)(t + 1) * kstep;
            const char* a2 = last ? nA : cA + (size_t)(t + 2) * kstep; const char* b2 = last ? nB : cB + (size_t)(t + 2) * kstep;
            const char* a3 = a2 + kstep; const char* b3 = b2 + kstep;
            if (last && has_next) S.a_ready(nxt);
            if constexpr (SP2) {
            PG8_LDB(B0, 0, 0); PG8_LDB(B1, 0, 1); PG8_SCHED; PG8_LDA(At, 0, 0); PG8_STAGE(PG8_SA(1, 1), a1 + hstep, voffA);
            PG8_WAIT_V(8); PG8_WAIT_L(0); PG8_BAR; PG8_MMA(0, 0, At, B0); PG8_MMA(0, 1, At, B1); PG8_BAR; PG8_SCHED;
            PG8_LDA(At, 0, 1); PG8_STAGE(PG8_SB(0, 0), b2, voffB); PG8_STAGE(PG8_SB(0, 1), b2 + hstep, voffB); PG8_STAGE(PG8_SA(0, 0), a2, voffA);
            PG8_WAIT_V(8); PG8_WAIT_L(0); PG8_BAR; PG8_MMA(1, 0, At, B0); PG8_MMA(1, 1, At, B1); PG8_BAR; PG8_SCHED;
            PG8_LDB(B0, 1, 0); PG8_LDB(B1, 1, 1); PG8_SCHED; PG8_LDA(At, 1, 0); PG8_STAGE(PG8_SA(0, 1), a2 + hstep, voffA);
            PG8_WAIT_V(8); PG8_WAIT_L(0); PG8_BAR; PG8_MMA(0, 0, At, B0); PG8_MMA(0, 1, At, B1); PG8_BAR; PG8_SCHED;
            PG8_LDA(At, 1, 1); PG8_STAGE(PG8_SB(1, 0), b3, voffB); PG8_STAGE(PG8_SB(1, 1), b3 + hstep, voffB); PG8_STAGE(PG8_SA(1, 0), a3, voffA);
            PG8_WAIT_V(8); PG8_WAIT_L(0); PG8_BAR; PG8_MMA(1, 0, At, B0); PG8_MMA(1, 1, At, B1); PG8_BAR; PG8_SCHED;
            } else {
            PG8_LDB(B0, 0, 0); PG8_SCHED; PG8_LDA(At, 0, 0); PG8_STAGE(PG8_SA(1, 1), a1 + hstep, voffA);
            PG8_WAIT_L(8); PG8_BAR; PG8_WAIT_L(0); PG8_MMA(0, 0, At, B0); PG8_BAR; PG8_SCHED;
            PG8_LDB(B1, 0, 1); PG8_STAGE(PG8_SB(0, 0), b2, voffB);
            PG8_BAR; PG8_WAIT_L(0); PG8_MMA(0, 1, At, B1); PG8_BAR;
            PG8_LDA(At, 0, 1); PG8_STAGE(PG8_SA(0, 0), a2, voffA);
            PG8_BAR; PG8_WAIT_L(0); PG8_MMA(1, 0, At, B0); PG8_BAR; PG8_SCHED;
            PG8_STAGE(PG8_SB(0, 1), b2 + hstep, voffB);
            PG8_WAIT_V(6); PG8_BAR; PG8_MMA(1, 1, At, B1); PG8_BAR;
            PG8_LDB(B0, 1, 0); PG8_SCHED; PG8_LDA(At, 1, 0); PG8_STAGE(PG8_SA(0, 1), a2 + hstep, voffA);
            PG8_WAIT_L(8); PG8_BAR; PG8_WAIT_L(0); PG8_MMA(0, 0, At, B0); PG8_BAR; PG8_SCHED;
            PG8_LDB(B1, 1, 1); PG8_STAGE(PG8_SB(1, 0), b3, voffB);
            PG8_BAR; PG8_WAIT_L(0); PG8_MMA(0, 1, At, B1); PG8_BAR;
            PG8_LDA(At, 1, 1); PG8_STAGE(PG8_SA(1, 0), a3, voffA);
            PG8_BAR; PG8_WAIT_L(0); PG8_MMA(1, 0, At, B0); PG8_BAR; PG8_SCHED;
            PG8_STAGE(PG8_SB(1, 1), b3 + hstep, voffB);
            PG8_WAIT_V(6); PG8_BAR; PG8_MMA(1, 1, At, B1); PG8_BAR;
            }
        }
#undef PG8_MSK
        }
        if constexpr (ALIGN_EPI) { if (wr == 0) PG8_BAR; }
        if constexpr (!Epi::AFTER_DRAIN) { E(acc, cur, wr, wc, fr, fq); S.done(cur); }
        if (!has_next) break;
#pragma unroll
        for (int a = 0; a < 2; ++a)
#pragma unroll
            for (int b = 0; b < 2; ++b)
#pragma unroll
                for (int m = 0; m < 4; ++m)
#pragma unroll
                    for (int n = 0; n < 2; ++n) acc[a][b][m][n] = (f32x4){0.f, 0.f, 0.f, 0.f};
        cur = nxt; cA = nA; cB = nB; ++ui;
        if constexpr (ALIGN_EPI) { if (wr == 1) PG8_BAR; }
    }
    PG8_WAIT_V(0);
    if constexpr (!ALIGN_EPI) { if (wr == 0) PG8_BAR; }
    PG8_BAR;
    if constexpr (Epi::AFTER_DRAIN) { E.fused(acc, cur, wr, wc, fr, fq, lds, wid, lane); S.done(cur); }
#undef PG8_SA
#undef PG8_SB
#undef PG8_STAGE
#undef PG8_LDA
#undef PG8_LDB
#undef PG8_MMA
#undef PG8_WAIT_V
#undef PG8_WAIT_L
#undef PG8_BAR
#undef PG8_SCHED
}
}
namespace att {
using bf16 = unsigned short;
constexpr int D = 128, NW = 8, QBLK = 32, KVBLK = 64;
constexpr float SCALE = 0.088388347648318440f;
constexpr float THR = 8.f;
constexpr int LDQ = 4608, LDK = 4608, LDO = 2048;
constexpr size_t SHM_V = KVBLK * D * 2, SHM_K = KVBLK * D * 2, SHM_ATTN = 2 * SHM_V + 2 * SHM_K + NW * 64 * 4;
constexpr int BIAS_OFF = 68 * 1024, QLDS_OFF = 72 * 1024;
using bf16x8 = __attribute__((ext_vector_type(8))) short;
using s16x4  = __attribute__((ext_vector_type(4))) short;
using f32x16 = __attribute__((ext_vector_type(16))) float;
using u32x4  = __attribute__((ext_vector_type(4))) unsigned;
#define KSWZ(row, colB) ((row) * 256 + ((colB) ^ (((row) & 7) << 4)))
#define SBAR() __builtin_amdgcn_sched_barrier(0)
__device__ __forceinline__ int crow(int r, int hi) { return (r & 3) + 8 * (r >> 2) + 4 * hi; }
__device__ __forceinline__ unsigned cvtpk(float lo, float hi) {
  unsigned r; asm volatile("v_cvt_pk_bf16_f32 %0, %1, %2" : "=v"(r) : "v"(lo), "v"(hi)); return r;
}
__device__ __forceinline__ float xs(float v, int o, int lane) { return __int_as_float(__builtin_amdgcn_ds_bpermute((lane ^ o) << 2, __float_as_int(v))); }
__device__ __forceinline__ float sumsq8(u32x4 w) { float q = 0.f;
#pragma unroll
  for (int e = 0; e < 4; ++e) { const float lo = __uint_as_float(w[e] << 16), hi = __uint_as_float(w[e] & 0xffff0000u); q += lo * lo + hi * hi; } return q; }
__device__ __forceinline__ void st16_wt(void* p, u32x4 v) { asm volatile("global_store_dwordx4 %0, %1, off sc0 sc1\n\ts_nop 1" :: "v"(p), "v"(v) : "memory"); }
__device__ __forceinline__ void partialSM(f32x16& p0, f32x16& p1, float& m_reg, float& mn, float& alpha) {
  constexpr float C = SCALE * 1.4426950408889634f;
  float pmax = p0[0]; for (int r = 1; r < 16; ++r) pmax = fmaxf(pmax, p0[r]); for (int r = 0; r < 16; ++r) pmax = fmaxf(pmax, p1[r]);
  { auto rr = __builtin_amdgcn_permlane32_swap(__float_as_uint(pmax), __float_as_uint(pmax), false, false);
    pmax = fmaxf(__uint_as_float(rr[0]), __uint_as_float(rr[1])); }
  if (__builtin_expect(__all(pmax - m_reg <= THR / SCALE), 1)) { mn = m_reg; alpha = 1.f; }
  else { mn = fmaxf(m_reg, pmax); alpha = __builtin_amdgcn_exp2f((m_reg - mn) * C); m_reg = mn; }
  float mnC = -mn * C;
  for (int r = 0; r < 16; ++r) p0[r] = fmaf(p0[r], C, mnC); for (int r = 0; r < 16; ++r) p1[r] = fmaf(p1[r], C, mnC);
  for (int r = 0; r < 16; ++r) p0[r] = __builtin_amdgcn_exp2f(p0[r]);
}
__device__ __forceinline__ void finishSM(f32x16& p0, f32x16& p1, float alpha, float& l_reg, bf16x8& pa0, bf16x8& pa1, bf16x8& pa2, bf16x8& pa3) {
  for (int r = 0; r < 16; ++r) p1[r] = __builtin_amdgcn_exp2f(p1[r]);
  float ps = 0; for (int r = 0; r < 16; ++r) ps += p0[r]; for (int r = 0; r < 16; ++r) ps += p1[r];
  { auto rr = __builtin_amdgcn_permlane32_swap(__float_as_uint(ps), __float_as_uint(ps), false, false);
    ps = __uint_as_float(rr[0]) + __uint_as_float(rr[1]); }
  l_reg = l_reg * alpha + ps;
#define PK4(P, BASE, OUT) do { unsigned a0 = cvtpk(P[BASE + 0], P[BASE + 1]), a1 = cvtpk(P[BASE + 2], P[BASE + 3]);   \
    unsigned b0 = cvtpk(P[BASE + 4], P[BASE + 5]), b1 = cvtpk(P[BASE + 6], P[BASE + 7]);                              \
    auto r0 = __builtin_amdgcn_permlane32_swap(a0, b0, false, false); auto r1 = __builtin_amdgcn_permlane32_swap(a1, b1, false, false); \
    u32x4 w = {r0[0], r1[0], r0[1], r1[1]}; OUT = *reinterpret_cast<bf16x8*>(&w); } while (0)
  PK4(p0, 0, pa0); PK4(p0, 8, pa1); PK4(p1, 0, pa2); PK4(p1, 8, pa3);
#undef PK4
}
template <bool QL>
__device__ __forceinline__ void qkt(f32x16& p0, f32x16& p1, const bf16* Ks, const bf16x8* qr, const char* ql, int r32, int hi) {
  p0 = f32x16{}; p1 = f32x16{};
  for (int d0 = 0; d0 < 8; ++d0) { int cb = (d0 * 16 + hi * 8) * 2;
    bf16x8 b0 = *reinterpret_cast<const bf16x8*>((const char*)Ks + KSWZ(r32, cb));
    bf16x8 b1 = *reinterpret_cast<const bf16x8*>((const char*)Ks + KSWZ(32 + r32, cb));
    bf16x8 q; if constexpr (QL) q = *reinterpret_cast<const bf16x8*>(ql + d0 * 1024); else q = qr[d0];
    p0 = __builtin_amdgcn_mfma_f32_32x32x16_bf16(b0, q, p0, 0, 0, 0);
    p1 = __builtin_amdgcn_mfma_f32_32x32x16_bf16(b1, q, p1, 0, 0, 0); }
}
__device__ __forceinline__ void na_mask(f32x16& p0, f32x16& p1, int kr, int r0, int qrow, int qc, int c0, int hi, const float* bl) {
  const bool tv = (kr >= r0) && (kr < r0 + 8);
  if (!tv) {
#pragma unroll
    for (int r = 0; r < 16; ++r) { p0[r] = -1e30f; p1[r] = -1e30f; }
  } else {
    const float* brow = bl + (kr - qrow + 7) * 31 + 15 - qc + 4 * hi;
    const int d = 4 * hi - c0;
#pragma unroll
    for (int r = 0; r < 16; ++r) {
      const int kc = (r & 3) + 8 * (r >> 2);
      const float b0 = brow[kc], b1 = brow[kc + 32];
      p0[r] = (unsigned)(d + kc) < 16u ? p0[r] + b0 : -1e30f; p1[r] = (unsigned)(d + kc + 32) < 16u ? p1[r] + b1 : -1e30f;
    }
  }
}
__device__ __forceinline__ int v_st(int k, int c) { const int kk = (k & ~0xC) | ((k & 4) << 1) | ((k & 8) >> 1); return ((kk >> 3) * 4 + (c >> 5)) * 512 + ((kk & 7) * 32 + (c & 31)) * 2; }
__device__ __forceinline__ int v_rd_base(int lane) { return ((lane & 3) << 3) | (((lane >> 2) & 3) << 6) | (((lane >> 4) & 1) << 5) | (((lane >> 5) & 1) << 8); }
constexpr int v_rd_off(int d0, int ks, int half) { return d0 * 512 + ks * 4096 + half * 2048; }
template <int OFF> __device__ __forceinline__ s16x4 tr_read(int vb) {
  s16x4 r; asm volatile("ds_read_b64_tr_b16 %0, %1 offset:%2" : "=&v"(r) : "v"(vb), "i"(OFF) : "memory"); return r;
}
template <int D0> __device__ __forceinline__ void pv_one(f32x16& od, int vb, bf16x8 pa0, bf16x8 pa1, bf16x8 pa2, bf16x8 pa3) {
  const s16x4 l0 = tr_read<v_rd_off(D0, 0, 0)>(vb), h0 = tr_read<v_rd_off(D0, 0, 1)>(vb), l1 = tr_read<v_rd_off(D0, 1, 0)>(vb), h1 = tr_read<v_rd_off(D0, 1, 1)>(vb);
  const s16x4 l2 = tr_read<v_rd_off(D0, 2, 0)>(vb), h2 = tr_read<v_rd_off(D0, 2, 1)>(vb), l3 = tr_read<v_rd_off(D0, 3, 0)>(vb), h3 = tr_read<v_rd_off(D0, 3, 1)>(vb);
  asm volatile("s_waitcnt lgkmcnt(0)" ::: "memory"); SBAR();
#define PK(L, H) (bf16x8){L[0], L[1], L[2], L[3], H[0], H[1], H[2], H[3]}
  od = __builtin_amdgcn_mfma_f32_32x32x16_bf16(pa0, PK(l0, h0), od, 0, 0, 0);
  od = __builtin_amdgcn_mfma_f32_32x32x16_bf16(pa1, PK(l1, h1), od, 0, 0, 0);
  od = __builtin_amdgcn_mfma_f32_32x32x16_bf16(pa2, PK(l2, h2), od, 0, 0, 0);
  od = __builtin_amdgcn_mfma_f32_32x32x16_bf16(pa3, PK(l3, h3), od, 0, 0, 0);
#undef PK
}
__device__ __forceinline__ void pv_d0(f32x16* o, int vb, bf16x8 pa0, bf16x8 pa1, bf16x8 pa2, bf16x8 pa3) {
  pv_one<0>(o[0], vb, pa0, pa1, pa2, pa3); pv_one<1>(o[1], vb, pa0, pa1, pa2, pa3); pv_one<2>(o[2], vb, pa0, pa1, pa2, pa3); pv_one<3>(o[3], vb, pa0, pa1, pa2, pa3);
}
template <bool NA, int SDEPTH, int LDKV>
__device__ __forceinline__ void attn_body(const bf16* __restrict__ Qb, const bf16* __restrict__ Kh, const bf16* __restrict__ Vh,
                                          bf16* __restrict__ Ob, int NT, char* lds, int qrow0, int kr_lo, const float* bl, const int tid, float* __restrict__ ssb) {
  const int wid = tid >> 6, lane = tid & 63, r32 = lane & 31, hi = lane >> 5;
  bf16* V_lds = (bf16*)lds; bf16* K_lds = (bf16*)(lds + 2 * SHM_V);
  float* ws = (float*)(lds + 2 * SHM_V + 2 * SHM_K) + wid * 64; float* li_l = ws; float* al_l = ws + 32;
  float m_reg = -1e30f, l_reg = 0; f32x16 o[4] = {}; bf16x8 qr[8];
  const int qrow = qrow0 + (wid >> 1), qc = 32 * (wid & 1) + r32;
  const int c0 = min(max(qc - 8, 0), 48), r0 = min(max(qrow - 4, 0), 120);
  const bf16* Qw = Qb + (long)(wid * QBLK + r32) * LDQ + hi * 8;
  char* ql = lds + QLDS_OFF + wid * 8192 + lane * 16;
  if constexpr (NA) {
#pragma unroll
    for (int d0 = 0; d0 < 8; ++d0) *reinterpret_cast<bf16x8*>(ql + d0 * 1024) = *reinterpret_cast<const bf16x8*>(Qw + d0 * 16);
  } else {
#pragma unroll
    for (int d0 = 0; d0 < 8; ++d0) qr[d0] = *reinterpret_cast<const bf16x8*>(Qw + d0 * 16);
  }
  const int sr = tid >> 4, sc = (tid & 15) * 8, vst0 = v_st(sr, sc), vst1 = v_st(32 + sr, sc);
  const int vb0 = (int)(uintptr_t)V_lds + v_rd_base(lane);
  struct { bf16x8 vs0, vs1, ks0, ks1; } sr_[SDEPTH];
#define SLOAD(i, k0) do { sr_[i].vs0 = *(const bf16x8*)(&Vh[(long)((k0) + sr) * LDKV + sc]); sr_[i].vs1 = *(const bf16x8*)(&Vh[(long)((k0) + 32 + sr) * LDKV + sc]); \
    sr_[i].ks0 = *(const bf16x8*)(&Kh[(long)((k0) + sr) * LDKV + sc]); sr_[i].ks1 = *(const bf16x8*)(&Kh[(long)((k0) + 32 + sr) * LDKV + sc]); } while (0)
#define SWRITE(b, i) do { *(bf16x8*)((char*)V_lds + (b) * SHM_V + vst0) = sr_[i].vs0;          \
    *(bf16x8*)((char*)V_lds + (b) * SHM_V + vst1) = sr_[i].vs1; int kc = sc * 2;               \
    *(bf16x8*)((char*)K_lds + (b) * SHM_K + KSWZ(sr, kc)) = sr_[i].ks0;                       \
    *(bf16x8*)((char*)K_lds + (b) * SHM_K + KSWZ(32 + sr, kc)) = sr_[i].ks1; } while (0)
#define SWAIT() do { if constexpr (SDEPTH == 2) asm volatile("s_waitcnt vmcnt(4)" ::: "memory"); else asm volatile("s_waitcnt vmcnt(0)" ::: "memory"); } while (0)
#define RESC(a) do { if (__any((a) < 1.f)) { if (hi == 0) al_l[r32] = (a); asm volatile("s_waitcnt lgkmcnt(0)" ::: "memory"); \
    for (int d = 0; d < 4; ++d) for (int r = 0; r < 16; ++r) o[d][r] *= al_l[crow(r, hi)]; } } while (0)
#define NAM(P0, P1, t) do { if constexpr (NA) na_mask(P0, P1, kr_lo + (t), r0, qrow, qc, c0, hi, bl); } while (0)
#define PSM(P0, P1, MN, AL) do { if constexpr (NA) partialSM(P0, P1, m_reg, MN, AL); else { AL = 1.f; _Pragma("unroll") for (int r = 0; r < 16; ++r) P0[r] = __builtin_amdgcn_exp2f(P0[r]); } } while (0)
#define RESCN(a) do { if constexpr (NA) RESC(a); } while (0)
  f32x16 pA0, pA1, pB0, pB1; float mnA, mnB, alA, alB; bf16x8 pa0, pa1, pa2, pa3;
  constexpr int SE = 0, SO = SDEPTH - 1;
  SLOAD(SE, 0); asm volatile("s_waitcnt vmcnt(0)" ::: "memory"); SWRITE(0, SE); __syncthreads();
  qkt<NA>(pA0, pA1, K_lds, qr, ql, r32, hi); NAM(pA0, pA1, 0); PSM(pA0, pA1, mnA, alA);
  SLOAD(SO, KVBLK); if constexpr (SDEPTH == 2) { if (2 < NT) SLOAD(SE, 2 * KVBLK); }
  SWAIT(); SWRITE(1, SO); __syncthreads();
  for (int j = 1; j + 1 < NT; j += 2) {
    SBAR(); qkt<NA>(pB0, pB1, (bf16*)((char*)K_lds + SHM_K), qr, ql, r32, hi); NAM(pB0, pB1, j);
    finishSM(pA0, pA1, alA, l_reg, pa0, pa1, pa2, pa3); SBAR();
    SLOAD(SO, (j + SDEPTH) * KVBLK); SBAR();
    pv_d0(o, vb0, pa0, pa1, pa2, pa3); PSM(pB0, pB1, mnB, alB);
    __syncthreads(); SWAIT(); SWRITE(0, SE);
    RESCN(alB); __syncthreads();
    SBAR(); qkt<NA>(pA0, pA1, K_lds, qr, ql, r32, hi); NAM(pA0, pA1, j + 1);
    finishSM(pB0, pB1, alB, l_reg, pa0, pa1, pa2, pa3); SBAR();
    if (SDEPTH == 1 || j + 3 < NT) SLOAD(SE, (j + 1 + SDEPTH) * KVBLK); SBAR();
    pv_d0(o, vb0 + (int)SHM_V, pa0, pa1, pa2, pa3); PSM(pA0, pA1, mnA, alA);
    __syncthreads(); SWAIT(); SWRITE(1, SO);
    RESCN(alA); __syncthreads();
  }
  SBAR(); qkt<NA>(pB0, pB1, (bf16*)((char*)K_lds + SHM_K), qr, ql, r32, hi); NAM(pB0, pB1, NT - 1);
  finishSM(pA0, pA1, alA, l_reg, pa0, pa1, pa2, pa3); SBAR();
  pv_d0(o, vb0, pa0, pa1, pa2, pa3); PSM(pB0, pB1, mnB, alB);
  __syncthreads(); RESCN(alB);
  finishSM(pB0, pB1, alB, l_reg, pa0, pa1, pa2, pa3); SBAR();
  pv_d0(o, vb0 + (int)SHM_V, pa0, pa1, pa2, pa3);
  if (hi == 0) li_l[r32] = l_reg; asm volatile("s_waitcnt lgkmcnt(0)" ::: "memory");
  float rli[16];
#pragma unroll
  for (int r = 0; r < 16; ++r) rli[r] = __builtin_amdgcn_rcpf(li_l[crow(r, hi)]);
  int tid_e = tid; asm volatile("" : "+v"(tid_e));
  const int lane_e = tid_e & 63, wid_e = tid_e >> 6, r32_e = lane_e & 31, hi_e = lane_e >> 5;
  bf16* Ow = Ob + (long)(wid_e * QBLK) * LDO;
  char* stg = lds + QLDS_OFF + wid_e * 8192;
  char* wb_e = stg + hi_e * 1024 + r32_e * 2 + hi_e * 64;
  char* wb_o = stg + hi_e * 1024 + r32_e * 2 - hi_e * 64;
#pragma unroll
  for (int r = 0; r < 16; ++r) { const int rc = ((r & 3) + 8 * (r >> 2)) * 256;
#pragma unroll
    for (int d0 = 0; d0 < 4; ++d0) { const float v = o[d0][r] * rli[r]; *(bf16*)(((d0 & 1) ? wb_o : wb_e) + rc + d0 * 64) = (bf16)(cvtpk(v, v) & 0xffffu); } }
  asm volatile("s_waitcnt lgkmcnt(0)" ::: "memory");
  const char* rb_e = stg + (lane_e >> 4) * 256 + (lane_e & 15) * 16;
  const char* rb_o = stg + (lane_e >> 4) * 256 + (((lane_e & 15) * 16) ^ 64);
  bf16* gb = Ow + (long)(lane_e >> 4) * LDO + (lane_e & 15) * 8;
#pragma unroll
  for (int i = 0; i < 8; ++i) { const u32x4 w = *(const u32x4*)(((i & 1) ? rb_o : rb_e) + i * 1024); st16_wt(gb + (long)i * 4 * LDO, w);
    float q = sumsq8(w); q += xs(q, 1, lane_e); q += xs(q, 2, lane_e); q += xs(q, 4, lane_e); q += xs(q, 8, lane_e);
    if ((lane_e & 15) == 0) ssb[(size_t)(wid_e * QBLK + (lane_e >> 4) + 4 * i) * 16] = q; }
  asm volatile("s_waitcnt lgkmcnt(0)" ::: "memory");
#undef SLOAD
#undef SWRITE
#undef SWAIT
#undef RESC
#undef NAM
#undef PSM
#undef RESCN
}

template <bool NA, int ROWB>
__device__ __forceinline__ void attn_dma(const bf16* __restrict__ Qb, const bf16* __restrict__ Kh, const bf16* __restrict__ Vh, bf16* __restrict__ Ob, int NT, char* lds, const int tid, float* __restrict__ ssb, int qrow0, int kr_lo, const float* bl) {
  const int wid = tid >> 6, lane = tid & 63, r32 = lane & 31, hi = lane >> 5;
  const int wid_s = __builtin_amdgcn_readfirstlane(wid);
  char* V_lds = lds; char* K_lds = lds + 3 * SHM_V;
  float* li_l = (float*)(lds + 3 * SHM_V + 3 * SHM_K) + wid * 64;
  float* al_l = li_l + 32;
  float m_reg = -1e30f, l_reg = 0; f32x16 o[4] = {}; bf16x8 qr[8];
  const int qrow = qrow0 + (wid >> 1), qc = 32 * (wid & 1) + r32;
  const int c0 = min(max(qc - 8, 0), 48), r0 = min(max(qrow - 4, 0), 120);
  const bf16* Qw = Qb + (long)(wid * QBLK + r32) * LDQ + hi * 8;
#pragma unroll
  for (int d0 = 0; d0 < 8; ++d0) qr[d0] = *reinterpret_cast<const bf16x8*>(Qw + d0 * 16);
  const int vb0 = (int)(uintptr_t)V_lds + v_rd_base(lane);
  auto src_off = [&](int i, unsigned& ko, unsigned& vo) __attribute__((always_inline)) {
    const int b = (wid * 2 + i) * 1024 + lane * 16;
    { const int row = b >> 8, cb = (b & 255) ^ ((row & 7) << 4); ko = (unsigned)(row * ROWB + cb); }
    { const int st = b >> 9, within = b & 511, kk = (st >> 2) * 8 + (within >> 6), c = (st & 3) * 32 + ((within & 63) >> 1);
      const int k = (kk & ~0xC) | ((kk & 4) << 1) | ((kk & 8) >> 1); vo = (unsigned)(k * ROWB + c * 2); }
  };
  unsigned ksrc[2], vsrc[2];
  if constexpr (!NA) { src_off(0, ksrc[0], vsrc[0]); src_off(1, ksrc[1], vsrc[1]); }
#define GAS3 __attribute__((address_space(3)))
#define DMA_TILE(t, b) do { const char* kt_ = (const char*)Kh + (size_t)(t) * (KVBLK * ROWB); const char* vt_ = (const char*)Vh + (size_t)(t) * (KVBLK * ROWB); \
    _Pragma("unroll") for (int i_ = 0; i_ < 2; ++i_) { unsigned ko_, vo_; if constexpr (NA) src_off(i_, ko_, vo_); else { ko_ = ksrc[i_]; vo_ = vsrc[i_]; } \
      __builtin_amdgcn_global_load_lds((const unsigned*)(kt_ + ko_), (GAS3 unsigned*)(K_lds + (b) * SHM_K + (wid_s * 2 + i_) * 1024), 16, 0, 0); \
      __builtin_amdgcn_global_load_lds((const unsigned*)(vt_ + vo_), (GAS3 unsigned*)(V_lds + (b) * SHM_V + (wid_s * 2 + i_) * 1024), 16, 0, 0); } } while (0)
#define VM0() asm volatile("s_waitcnt vmcnt(0)" ::: "memory")
#define RESC(a) do { if (__any((a) < 1.f)) { if (hi == 0) al_l[r32] = (a); asm volatile("s_waitcnt lgkmcnt(0)" ::: "memory"); \
    for (int d = 0; d < 4; ++d) for (int r = 0; r < 16; ++r) o[d][r] *= al_l[crow(r, hi)]; } } while (0)
#define NAM(P0, P1, t) do { if constexpr (NA) na_mask(P0, P1, kr_lo + (t), r0, qrow, qc, c0, hi, bl); } while (0)
#define PSM(P0, P1, MN, AL) do { if constexpr (NA) partialSM(P0, P1, m_reg, MN, AL); else { AL = 1.f; _Pragma("unroll") for (int r = 0; r < 16; ++r) P0[r] = __builtin_amdgcn_exp2f(P0[r]); } } while (0)
#define RESCN(a) do { if constexpr (NA) RESC(a); } while (0)
#define NEXTB(b) ((b) == 2 ? 0 : (b) + 1)
  f32x16 pA0, pA1, pB0, pB1; bf16x8 pa0, pa1, pa2, pa3; float mnA, mnB, alA, alB;
  DMA_TILE(0, 0); DMA_TILE(1, 1); VM0(); __syncthreads();
  qkt<false>(pA0, pA1, (const bf16*)K_lds, qr, nullptr, r32, hi); NAM(pA0, pA1, 0); PSM(pA0, pA1, mnA, alA);
  int bp = 0, bc = 1, bn = 2;
  for (int t = 1; t + 1 < NT; t += 2) {
    DMA_TILE(t + 1, bn);
    SBAR(); qkt<false>(pB0, pB1, (const bf16*)(K_lds + bc * SHM_K), qr, nullptr, r32, hi); NAM(pB0, pB1, t);
    finishSM(pA0, pA1, alA, l_reg, pa0, pa1, pa2, pa3); SBAR();
    pv_d0(o, vb0 + bp * (int)SHM_V, pa0, pa1, pa2, pa3); PSM(pB0, pB1, mnB, alB); RESCN(alB);
    VM0(); __syncthreads();
    bp = bc; bc = bn; bn = NEXTB(bn);
    if (t + 2 < NT) DMA_TILE(t + 2, bn);
    SBAR(); qkt<false>(pA0, pA1, (const bf16*)(K_lds + bc * SHM_K), qr, nullptr, r32, hi); NAM(pA0, pA1, t + 1);
    finishSM(pB0, pB1, alB, l_reg, pa0, pa1, pa2, pa3); SBAR();
    pv_d0(o, vb0 + bp * (int)SHM_V, pa0, pa1, pa2, pa3); PSM(pA0, pA1, mnA, alA); RESCN(alA);
    VM0(); __syncthreads();
    bp = bc; bc = bn; bn = NEXTB(bn);
  }
  SBAR(); qkt<false>(pB0, pB1, (const bf16*)(K_lds + bc * SHM_K), qr, nullptr, r32, hi); NAM(pB0, pB1, NT - 1);
  finishSM(pA0, pA1, alA, l_reg, pa0, pa1, pa2, pa3); SBAR();
  pv_d0(o, vb0 + bp * (int)SHM_V, pa0, pa1, pa2, pa3); PSM(pB0, pB1, mnB, alB); RESCN(alB);
  finishSM(pB0, pB1, alB, l_reg, pa0, pa1, pa2, pa3); SBAR();
  pv_d0(o, vb0 + bc * (int)SHM_V, pa0, pa1, pa2, pa3);
  if (hi == 0) li_l[r32] = l_reg; asm volatile("s_waitcnt lgkmcnt(0)" ::: "memory");
  float rli[16];
#pragma unroll
  for (int r = 0; r < 16; ++r) rli[r] = __builtin_amdgcn_rcpf(li_l[crow(r, hi)]);
  bf16* Ow = Ob + (long)(wid * QBLK) * LDO;
#undef DMA_TILE
#undef VM0
#undef RESC
#undef NAM
#undef PSM
#undef RESCN
#undef NEXTB
#undef GAS3
  int tid_e = tid; asm volatile("" : "+v"(tid_e));
  const int lane_e = tid_e & 63, wid_e = tid_e >> 6, r32_e = lane_e & 31, hi_e = lane_e >> 5;
  char* sg = lds + 100 * 1024 + wid_e * 4096;
#pragma unroll
  for (int half = 0; half < 2; ++half) {
    char* wb_e = sg + hi_e * 1024 + r32_e * 2 + hi_e * 64;
    char* wb_o = sg + hi_e * 1024 + r32_e * 2 - hi_e * 64;
#pragma unroll
    for (int rr = 0; rr < 8; ++rr) { const int r = half * 8 + rr; const int rc = ((rr & 3) + 8 * (rr >> 2)) * 256;
#pragma unroll
      for (int d0 = 0; d0 < 4; ++d0) { const float v = o[d0][r] * rli[r]; *(bf16*)(((d0 & 1) ? wb_o : wb_e) + rc + d0 * 64) = (bf16)(cvtpk(v, v) & 0xffffu); } }
    asm volatile("s_waitcnt lgkmcnt(0)" ::: "memory");
    const char* rb_e = sg + (lane_e >> 4) * 256 + (lane_e & 15) * 16;
    const char* rb_o = sg + (lane_e >> 4) * 256 + (((lane_e & 15) * 16) ^ 64);
    bf16* gb = Ow + (long)(half * 16 + (lane_e >> 4)) * LDO + (lane_e & 15) * 8;
#pragma unroll
    for (int i = 0; i < 4; ++i) { const u32x4 w = *(const u32x4*)(((i & 1) ? rb_o : rb_e) + i * 1024); st16_wt(gb + (long)i * 4 * LDO, w);
      float q = sumsq8(w); q += xs(q, 1, lane_e); q += xs(q, 2, lane_e); q += xs(q, 4, lane_e); q += xs(q, 8, lane_e);
      if ((lane_e & 15) == 0) ssb[(size_t)(wid_e * QBLK + half * 16 + (lane_e >> 4) + 4 * i) * 16] = q; }
    asm volatile("s_waitcnt lgkmcnt(0)" ::: "memory");
  }
}
#undef SBAR
#undef KSWZ
}
#define LAS __attribute__((address_space(3)))
typedef unsigned short bf16_t;
typedef float f32x4 __attribute__((ext_vector_type(4)));
typedef unsigned u32x4 __attribute__((ext_vector_type(4)));
typedef unsigned u32x2 __attribute__((ext_vector_type(2)));
#ifndef PHMASK
#define PHMASK 255
#endif
#ifndef PROBE_DUP
#define PROBE_DUP 0
#endif
#ifndef FUSE_LN
#define FUSE_LN 1
#endif
#ifndef GQA_SDEPTH
#define GQA_SDEPTH 1
#endif
#ifndef MK_PER_PHASE_LAUNCH
#define MK_PER_PHASE_LAUNCH 0
#endif
constexpr int SEQ = 8192, DM = 2048, DFF = 5632, DIN = 4608, NLAYER = 2, NGU = 2 * DFF;
constexpr int NPHASE = 1 + 12 * NLAYER;
constexpr float ALPHA = 1.4142135623730951f, LN_EPS = 1e-5f, RMS_EPS = 1e-6f;
constexpr int LDS_BYTES = 147456;
constexpr size_t SZ_WGU = (size_t)NGU * DM * 2, SZ_WD = (size_t)DM * DFF * 2, SZ_WIN = (size_t)DIN * DM * 2, SZ_WOUT = (size_t)DM * DM * 2;
constexpr size_t OFF_WGU = 0, OFF_WD = OFF_WGU + 4 * SZ_WGU, OFF_WIN = OFF_WD + 4 * SZ_WD, OFF_WOUT = OFF_WIN + 2 * SZ_WIN;
constexpr size_t OFF_XF = OFF_WOUT + 2 * SZ_WOUT, OFF_XB = OFF_XF + (size_t)SEQ * DM * 4, OFF_HID = OFF_XB + (size_t)SEQ * DM * 2;
constexpr size_t OFF_H = OFF_HID + (size_t)SEQ * DFF * 2, OFF_OB = OFF_H + (size_t)SEQ * DIN * 2, WS_END = OFF_OB + (size_t)SEQ * DM * 2;
constexpr size_t OFF_BAR = WS_END, BAR_BYTES = 262144;
constexpr size_t OFF_CNT = OFF_BAR + 16384, OFF_XBUF = OFF_BAR + BAR_BYTES, OFF_SS = OFF_XBUF + (size_t)SEQ * 8 * 8, OFF_KC = OFF_SS + (size_t)SEQ * 16 * 4,     WS_TOTAL = OFF_KC + (size_t)4 * SEQ * 128 * 2;
constexpr int MISC_OFF = LDS_BYTES - 64;
constexpr size_t OFF_O = OFF_HID;
static_assert((size_t)SEQ * DM * 4 <= (size_t)SEQ * DFF * 2, "O overlay fits");

#define XB_TMO      128
#define XB_XCNT(j)  (256  + 64 * (j))
#define XB_XSUB(j)  (1280 + 64 * (j))
#define XB_XGEN(j)  (2304 + 64 * (j))
#define XB_TOP      3328
#define XB_TOPGEN   3392
#define XCD_BAR_WORDS 3456
#define XB_SPIN_CAP (1u << 18)

__device__ __forceinline__ unsigned xb_ld(unsigned* p)              { return __hip_atomic_load(p, __ATOMIC_RELAXED, __HIP_MEMORY_SCOPE_AGENT); }
__device__ __forceinline__ unsigned xb_add(unsigned* p, unsigned v) { return __hip_atomic_fetch_add(p, v, __ATOMIC_RELAXED, __HIP_MEMORY_SCOPE_AGENT); }
__device__ __forceinline__ unsigned xb_xcc_id() { return (unsigned)__builtin_amdgcn_s_getreg((3 << 11) | 20) & 0xFu; }
#define XB_SPIN(cond, bar) do { unsigned _sp = 0; while (cond) { __builtin_amdgcn_s_sleep(1); \
    if ((++_sp & 255u) == 0u) { if (xb_ld(&(bar)[XB_TMO])) break; if (_sp > XB_SPIN_CAP) { atomicAdd(&(bar)[XB_TMO], 1u); break; } } } } while (0)

struct XcdBarrier {
    unsigned* bar; unsigned x;
    volatile LAS unsigned* st;
};

__device__ __forceinline__ XcdBarrier xcd_barrier_post(unsigned* bar, volatile LAS unsigned* st) {
    XcdBarrier b; b.bar = bar; b.x = xb_xcc_id(); b.st = st;
    if (threadIdx.x == 0) (void)xb_add(&bar[XB_XCNT(b.x)], 1u);
    return b;
}
__device__ __forceinline__ void xcd_barrier_complete(unsigned* bar, unsigned x, unsigned& nloc, unsigned& nx) {
    const unsigned G = gridDim.x * gridDim.y * gridDim.z;
    unsigned sum, cnt, mine, sp = 0u;
    for (;;) {
        sum = 0u; cnt = 0u; mine = 0u;
#pragma unroll
        for (unsigned j = 0; j < 16; ++j) { const unsigned c = xb_ld(&bar[XB_XCNT(j)]); sum += c; cnt += (c > 0u) ? 1u : 0u; mine = (j == x) ? c : mine; }
        if (sum == G) break;
        __builtin_amdgcn_s_sleep(1);
        if ((++sp & 255u) == 0u) { if (xb_ld(&bar[XB_TMO])) break; if (sp > XB_SPIN_CAP) { atomicAdd(&bar[XB_TMO], 1u); break; } }
    }
    nloc = mine > 0u ? mine : 1u; nx = cnt > 0u ? cnt : 1u;
}

__device__ __forceinline__ void xcd_barrier(const XcdBarrier& b) {
    asm volatile("s_waitcnt vmcnt(0)" ::: "memory");
    __syncthreads();
    if (threadIdx.x == 0) {
        unsigned* bar = b.bar;
        __builtin_amdgcn_s_waitcnt(0);
        unsigned nloc = b.st[0], nx = b.st[1];
        if (nloc == 0u) { xcd_barrier_complete(bar, b.x, nloc, nx); b.st[0] = nloc; b.st[1] = nx; }
        const unsigned old = xb_add(&bar[XB_XSUB(b.x)], 1u);
        const unsigned gen = old / nloc;
        if (old + 1u == (gen + 1u) * nloc) {
            __builtin_amdgcn_fence(__ATOMIC_RELEASE, "agent");
            asm volatile("s_waitcnt vmcnt(0)" ::: "memory");
            const unsigned og = xb_add(&bar[XB_TOP], 1u);
            const unsigned tg = og / nx;
            if (og + 1u == (tg + 1u) * nx) xb_add(&bar[XB_TOPGEN], 1u);
            else XB_SPIN(xb_ld(&bar[XB_TOPGEN]) == tg, bar);
            __builtin_amdgcn_fence(__ATOMIC_ACQUIRE, "agent");
            xb_add(&bar[XB_XGEN(b.x)], 1u);
            asm volatile("s_waitcnt vmcnt(0)" ::: "memory");
        } else {
            XB_SPIN(xb_ld(&bar[XB_XGEN(b.x)]) == gen, bar);
            __builtin_amdgcn_fence(__ATOMIC_ACQUIRE, "agent");
            asm volatile("s_waitcnt vmcnt(0)" ::: "memory");
        }
    }
    __syncthreads();
}

__device__ __forceinline__ unsigned pk2(float lo, float hi) { unsigned r; asm volatile("v_cvt_pk_bf16_f32 %0, %1, %2" : "=v"(r) : "v"(lo), "v"(hi)); return r; }
__device__ __forceinline__ float wave_sum(float v, int lane) {
#pragma unroll
    for (int o = 1; o < 64; o <<= 1) v += pg8::xshfl(v, o, lane);
    return v;
}
__device__ __forceinline__ void transpose_item(const float* __restrict__ W, int K, int N, bf16_t* __restrict__ WT, int drow0, LAS float* scr, int k0, int n0, int lane, const float* __restrict__ gk) {
    const float* src = W + (size_t)k0 * N + n0 + lane;
#pragma unroll
    for (int hb = 0; hb < 1; ++hb) {
        float v[64];
#pragma unroll
        for (int i = 0; i < 64; ++i) v[i] = src[(size_t)(hb * 64 + i) * N];
        if (gk) {
#pragma unroll
            for (int i = 0; i < 64; ++i) v[i] *= gk[k0 + hb * 64 + i];
        }
#pragma unroll
        for (int i = 0; i < 64; ++i) scr[(hb * 64 + i) * 65 + lane] = v[i];
    }
    asm volatile("s_waitcnt lgkmcnt(0)" ::: "memory");
    const int c = lane & 7;
#pragma unroll
    for (int j = 0; j < 8; ++j) { const int n = (lane >> 3) + 8 * j; const LAS float* s = scr + (8 * c) * 65 + n;
        u32x4 o; o.x = pk2(s[0 * 65], s[1 * 65]); o.y = pk2(s[2 * 65], s[3 * 65]); o.z = pk2(s[4 * 65], s[5 * 65]); o.w = pk2(s[6 * 65], s[7 * 65]);
        *(u32x4*)(WT + (size_t)(drow0 + n) * K + k0 + 8 * c) = o; }
    asm volatile("s_waitcnt lgkmcnt(0)" ::: "memory");
}
__device__ __forceinline__ void transpose_matrix(const float* W, int K, int N, bf16_t* WT, int mode, LAS float* scr, int gw, int NGW, int lane, const float* gA, const float* gB, int it_lo, int it_hi) {
    const int nblk = N / 64, w8 = gw & 7;
    for (int j = (it_lo >> 3) + (gw >> 3); j < (it_hi >> 3); j += (NGW >> 3)) {
        const int kb = (j / nblk) * 8 + w8, nb = j % nblk, n0 = nb * 64;
        int drow0 = n0;
        if (mode) { const int up = n0 >= DFF, j = n0 - up * DFF; drow0 = 256 * (j / 128) + (j % 128) + up * 128; }
        transpose_item(W, K, N, WT, drow0, scr, kb * 64, n0, lane, gA ? (kb * 64 < 1024 ? gA : gB - 1024) : nullptr);
    }
}
constexpr int CQ1 = 5400, CQ2 = 14096, CQ3 = 20400, CQ4 = 25600, CQ5 = 32304, CQ6 = 34816;
static_assert(CQ1 % 8 == 0 && CQ2 % 8 == 0 && CQ3 % 8 == 0 && CQ4 % 8 == 0 && CQ5 % 8 == 0 && CQ6 % 8 == 0, "slot boundaries in units of 8 items");
constexpr int QN_D = (DFF / 64) * (DM / 64), QN_GU = (DM / 64) * (NGU / 64), QN_IN = (DM / 64) * (DIN / 64), QN_OUT = (DM / 64) * (DM / 64);
static_assert(3 * QN_GU + 4 * QN_D + 2 * QN_IN + 2 * QN_OUT == CQ6, "conversion queue length");
static_assert(CQ1 >= QN_D + QN_IN && CQ2 >= QN_D + QN_IN + QN_OUT + QN_GU && CQ3 >= 2 * QN_D + QN_IN + QN_OUT + 2 * QN_GU && CQ4 >= 3 * QN_D + 2 * QN_IN + QN_OUT + 2 * QN_GU && CQ5 >= 3 * QN_D + 2 * QN_IN + 2 * QN_OUT + 3 * QN_GU, "each matrix is converted before the phase that first reads it");
template <class ArgsP>
__device__ __forceinline__ void convert_queue(ArgsP ap, unsigned char* ws, int q_lo, int q_hi, LAS float* scr, int gw, int NGW, int lane) {
    int off = 0;
#pragma unroll 1
    for (int qi = 0; qi < 11; ++qi) {
        const int l = qi >= 5, f = (qi == 3 || qi == 4 || qi == 9 || qi == 10);
        const bool isgu = (qi == 3 || qi == 5 || qi == 9), isin = (qi == 1 || qi == 7), isout = (qi == 2 || qi == 8);
        const int n = isgu ? QN_GU : isin ? QN_IN : isout ? QN_OUT : QN_D;
        const int lo = max(q_lo - off, 0), hi = min(q_hi - off, n);
        if (lo < hi) {
            if (isgu) transpose_matrix((f ? ap->in[14] : ap->in[1]) + (size_t)l * DM * NGU, DM, NGU, (bf16_t*)(ws + OFF_WGU + (size_t)(l * 2 + f) * SZ_WGU), 1, scr, gw, NGW, lane, nullptr, nullptr, lo, hi);
            else if (isin) transpose_matrix(ap->in[5] + (size_t)l * DM * DIN, DM, DIN, (bf16_t*)(ws + OFF_WIN + (size_t)l * SZ_WIN), 0, scr, gw, NGW, lane, nullptr, nullptr, lo, hi);
            else if (isout) transpose_matrix(ap->in[11] + (size_t)l * DM * DM, DM, DM, (bf16_t*)(ws + OFF_WOUT + (size_t)l * SZ_WOUT), 0, scr, gw, NGW, lane, ap->in[9] + (size_t)l * 1024, ap->in[10] + (size_t)l * 1024, lo, hi);
            else transpose_matrix((f ? ap->in[15] : ap->in[2]) + (size_t)l * DFF * DM, DFF, DM, (bf16_t*)(ws + OFF_WD + (size_t)(l * 2 + f) * SZ_WD), 0, scr, gw, NGW, lane, nullptr, nullptr, lo, hi);
        }
        off += n;
    }
}
__device__ __forceinline__ void group_stats_rows(const bf16_t* OB, float* RS, int gw, int NGW, int lane) {
    for (int row0 = gw; row0 < SEQ; row0 += 4 * NGW) {
        u32x4 w[4][4];
#pragma unroll
        for (int k = 0; k < 4; ++k)
#pragma unroll
            for (int j = 0; j < 4; ++j) w[k][j] = ((const u32x4*)(OB + (size_t)(row0 + k * NGW) * DM) + lane)[64 * j];
#pragma unroll
        for (int k = 0; k < 4; ++k) {
            float sa = 0.f, sb = 0.f;
#pragma unroll
            for (int j = 0; j < 4; ++j) { float q = 0.f;
#pragma unroll
                for (int e = 0; e < 4; ++e) { const float lo = __uint_as_float(w[k][j][e] << 16), hi = __uint_as_float(w[k][j][e] & 0xffff0000u); q += lo * lo + hi * hi; }
                if (j < 2) sa += q; else sb += q; }
            const float ra = 1.f / sqrtf(wave_sum(sa, lane) * (1.f / 1024.f) + RMS_EPS), rb = 1.f / sqrtf(wave_sum(sb, lane) * (1.f / 1024.f) + RMS_EPS);
            if (lane == 0) { RS[2 * (row0 + k * NGW)] = ra / rb; RS[2 * (row0 + k * NGW) + 1] = rb; }
        }
    }
}
__device__ __forceinline__ void qk_prep(bf16_t* H, bf16_t* KC, bf16_t* VC, const float* __restrict__ qg, const float* __restrict__ kg, int gw, int NGW, int lane) {
    const int q16 = lane & 15, half = q16 >> 3, i0 = 8 * (q16 & 3); const bool first = (q16 & 7) < 4;
    float invf[8];
#pragma unroll
    for (int e = 0; e < 8; ++e) invf[e] = __builtin_amdgcn_exp2f(-(float)(i0 + e) * (13.287712379549449f / 32.f));
    for (int t0 = gw; t0 < SEQ; t0 += 4 * NGW) {
      u32x4 wq[4][3];
#pragma unroll
      for (int kk = 0; kk < 4; ++kk)
#pragma unroll
        for (int k = 0; k < 3; ++k) wq[kk][k] = ((const u32x4*)(H + (size_t)(t0 + kk * NGW) * DIN + 3072))[lane + 64 * k];
#pragma unroll
      for (int kk = 0; kk < 4; ++kk) {
        const int t = t0 + kk * NGW;
        u32x4* src = (u32x4*)(H + (size_t)t * DIN + 3072);
        const float pos = (float)(half ? (t & 63) : (t >> 6));
        u32x4 w[3];
#pragma unroll
        for (int k = 0; k < 3; ++k) w[k] = wq[kk][k];
#pragma unroll
        for (int k = 0; k < 3; ++k) {
            float x[8];
#pragma unroll
            for (int e = 0; e < 4; ++e) { x[2 * e] = __uint_as_float(w[k][e] << 16); x[2 * e + 1] = __uint_as_float(w[k][e] & 0xffff0000u); }
            float ss = 0.f;
#pragma unroll
            for (int e = 0; e < 8; ++e) ss += x[e] * x[e];
            ss += pg8::xshfl(ss, 1, lane); ss += pg8::xshfl(ss, 2, lane); ss += pg8::xshfl(ss, 4, lane); ss += pg8::xshfl(ss, 8, lane);
            const float rstd = 1.f / sqrtf(ss * (1.f / 128.f) + RMS_EPS);
            const float* g = (k < 2 ? qg : kg) + 8 * q16;
            float o[8];
#pragma unroll
            for (int e = 0; e < 8; ++e) { const float y = x[e] * rstd * g[e], yp = pg8::xshfl(y, 4, lane); const float ang = pos * invf[e], cs = __cosf(ang), sn = __sinf(ang);
                o[e] = first ? y * cs - yp * sn : y * cs + yp * sn; if (k < 2) o[e] *= (att::SCALE * 1.4426950408889634f); }
            u32x4 r; r.x = pk2(o[0], o[1]); r.y = pk2(o[2], o[3]); r.z = pk2(o[4], o[5]); r.w = pk2(o[6], o[7]);
            if (k < 2) src[lane + 64 * k] = r;
            else if (lane < 32) *(u32x4*)(KC + ((size_t)(lane >> 4) * SEQ + t) * 128 + 8 * q16) = r;
            else *(u32x4*)(VC + ((size_t)((lane - 32) >> 4) * SEQ + t) * 128 + 8 * q16) = w[2];
        }
      }
    }
}

struct Args { const float* in[18]; float* out; unsigned char* ws; int ph_lo, ph_hi; };
__global__ void __launch_bounds__(512, 2) fwd_megakernel(Args a) {
    extern __shared__ __attribute__((aligned(16))) unsigned char lds[];
    cg::grid_group grid = cg::this_grid();
    const int ph_lo = a.ph_lo, ph_hi = a.ph_hi;
    if (threadIdx.x < 16) ((LAS unsigned*)((LAS unsigned char*)lds + MISC_OFF))[threadIdx.x] = 0u;
    __syncthreads();
    const XcdBarrier xbar = xcd_barrier_post((unsigned*)(a.ws + OFF_BAR), (volatile LAS unsigned*)((LAS unsigned char*)lds + MISC_OFF));
    const int wave_s = __builtin_amdgcn_readfirstlane((int)threadIdx.x >> 6);
    for (int ph = ph_lo; ph < ph_hi; ++ph) {
        const int kind_ = ph == 0 ? -1 : (ph - 1) % 12;
        if (kind_ == 2 || kind_ == 8 || kind_ == 11 || kind_ == 6) continue;
        if (ph > ph_lo) { if (ph == ph_lo + 1 && ph_lo != 0) grid.sync(); else xcd_barrier(xbar); if (PROBE_DUP & 32) xcd_barrier(xbar); }
        const int nrep = ((kind_ == -1 && (PROBE_DUP & 1)) || ((kind_ == 0 || kind_ == 9) && (PROBE_DUP & 2)) || (kind_ == 3 && (PROBE_DUP & 4)) || (kind_ == 5 && (PROBE_DUP & 8)) || (kind_ == 6 && (PROBE_DUP & 16))) ? 2 : 1;
        for (int rep = 0; rep < nrep; ++rep) {
        const __attribute__((address_space(4))) Args* ap = (const __attribute__((address_space(4))) Args*)__builtin_amdgcn_kernarg_segment_ptr();
        asm volatile("" : "+s"(ap) :: "memory");
#define a (*ap)
        int lane_; asm volatile("v_mbcnt_lo_u32_b32 %0, -1, 0\n\tv_mbcnt_hi_u32_b32 %0, -1, %0" : "=v"(lane_));
        int tid = wave_s * 64 + lane_; asm volatile("" : "+v"(tid));
        const int lane = tid & 63, wave = __builtin_amdgcn_readfirstlane(tid >> 6);
        const int G = gridDim.x, gw = blockIdx.x * 8 + wave, NGW = G * 8;
        unsigned char* ws = a.ws;
        bf16_t* const XB = (bf16_t*)(ws + OFF_XB); float* const XF = (float*)(ws + OFF_XF); bf16_t* const HID = (bf16_t*)(ws + OFF_HID);
        bf16_t* const Hb = (bf16_t*)(ws + OFF_H); bf16_t* const KC = (bf16_t*)(ws + OFF_KC); bf16_t* const VC = KC + (size_t)2 * SEQ * 128; float* const Of = (float*)(ws + OFF_O); bf16_t* const OB = (bf16_t*)(ws + OFF_OB);
        if (ph == 0 && (PHMASK & 1)) {
            LAS float* scr = (LAS float*)((LAS unsigned char*)lds + wave * 16640);
            transpose_matrix(a.in[1], DM, NGU, (bf16_t*)(ws + OFF_WGU), 1, scr, gw, NGW, lane, nullptr, nullptr, 0, QN_GU);
            const f32x4* xs = (const f32x4*)a.in[0]; u32x2* xd = (u32x2*)XB;
            for (int p0 = blockIdx.x * 512 + tid; p0 < SEQ * DM / 8; p0 += G * 512 * 8) {
                f32x4 v[8][2];
#pragma unroll
                for (int j = 0; j < 8; ++j) { v[j][0] = xs[2 * (p0 + j * G * 512)]; v[j][1] = xs[2 * (p0 + j * G * 512) + 1]; }
#pragma unroll
                for (int j = 0; j < 8; ++j) { u32x4 w; w.x = pk2(v[j][0].x, v[j][0].y); w.y = pk2(v[j][0].z, v[j][0].w); w.z = pk2(v[j][1].x, v[j][1].y); w.w = pk2(v[j][1].z, v[j][1].w);
                    ((u32x4*)xd)[p0 + j * G * 512] = w; }
            }
            __syncthreads();
            continue;
        }
        const int l = (ph - 1) / 12, kind = (ph - 1) % 12;
        if ((kind == 0 || kind == 9) && (PHMASK & 2)) {
            const int f = kind == 9;
            pg8::Gemm g{XB, (const bf16_t*)(ws + OFF_WGU + (size_t)(l * 2 + f) * SZ_WGU), SEQ, NGU, DM};
            pg8::TailOrder S; S.init(SEQ, NGU, G, (int)blockIdx.x, 1);
            pg8::EpiSwiGLU E{HID, DFF};
            pg8::gemm_phase<pg8::EpiSwiGLU, pg8::TailOrder, true, true>((LAS unsigned char*)lds, g, S, E, tid);
            { const int idle0 = (SEQ / 256) * (NGU / 256) % G;
              const int q_lo = l == 0 ? (f ? CQ2 : 0) : (f ? CQ5 : CQ3), q_hi = l == 0 ? (f ? CQ3 : CQ1) : (f ? CQ6 : CQ4);
              if (idle0 > 0 && (int)blockIdx.x >= idle0) convert_queue(ap, ws, q_lo, q_hi, (LAS float*)((LAS unsigned char*)lds + wave * 16640), ((int)blockIdx.x - idle0) * 8 + wave, (G - idle0) * 8, lane); }
        } else if ((kind == 1 || kind == 10 || kind == 7) && (PHMASK & 4)) {
            const int f = kind == 10;
            const bool wo = kind == 7;
            pg8::Gemm g{wo ? OB : HID, (const bf16_t*)(wo ? ws + OFF_WOUT + (size_t)l * SZ_WOUT : ws + OFF_WD + (size_t)(l * 2 + f) * SZ_WD), SEQ, DM, wo ? DM : DFF};
            pg8::StaticOrder S; S.init(SEQ, DM, G, (int)blockIdx.x);
            {
                const int gi = kind == 1 ? 3 : kind == 7 ? 12 : 16;
                float* dst = (kind == 10 && l == NLAYER - 1) ? a.out : (float*)nullptr;
                pg8::PanelStats8 st{(unsigned long long*)(ws + OFF_XBUF), (unsigned*)(ws + OFF_CNT) + (size_t)ph * 2048, LN_EPS};
                LAS float* rsl = (LAS float*)((LAS unsigned char*)lds + 132 * 1024);
                if (wo) {
                    pg8::Unit u0; S.next(0, u0);
                    const f32x4* sp = (const f32x4*)((const float*)(ws + OFF_SS) + (size_t)(u0.pm * 256 + (tid >> 1)) * 16 + (tid & 1) * 8);
                    const f32x4 s0 = sp[0], s1 = sp[1];
                    const float ssum = ((s0.x + s0.y) + (s0.z + s0.w)) + ((s1.x + s1.y) + (s1.z + s1.w));
                    const float rme = 1.f / sqrtf(ssum * (1.f / 1024.f) + RMS_EPS), rot = pg8::xshfl(rme, 1, lane);
                    if (!(tid & 1)) { rsl[2 * (tid >> 1)] = rme / rot; rsl[2 * (tid >> 1) + 1] = rot; }
                    __syncthreads();
                }
                pg8::EpiResidLn E{XB, dst, XB, DM, ALPHA, wo ? 1.0f : 0.5f, a.in[gi] + (size_t)l * DM, a.in[gi + 1] + (size_t)l * DM, st, rsl, wo ? 1 : 0};
                pg8::gemm_phase<pg8::EpiResidLn, pg8::StaticOrder, false, true>((LAS unsigned char*)lds, g, S, E, tid);
            }
        } else if (kind == 3 && (PHMASK & 16)) {
            pg8::Gemm g{XB, (const bf16_t*)(ws + OFF_WIN + (size_t)l * SZ_WIN), SEQ, DIN, DM};
            pg8::TailOrder S; S.init(SEQ, DIN, G, (int)blockIdx.x, 1);
            pg8::EpiBf16<0> E{Hb, DIN, nullptr, 0, 0, 1.f};
            pg8::gemm_phase<pg8::EpiBf16<0>, pg8::TailOrder, true, true>((LAS unsigned char*)lds, g, S, E, tid);
            { const int idle0 = (SEQ / 256) * (DIN / 256) % G;
              const int q_lo = l == 0 ? CQ1 : CQ4, q_hi = l == 0 ? CQ2 : CQ5;
              if (idle0 > 0 && (int)blockIdx.x >= idle0) convert_queue(ap, ws, q_lo, q_hi, (LAS float*)((LAS unsigned char*)lds + wave * 16640), ((int)blockIdx.x - idle0) * 8 + wave, (G - idle0) * 8, lane); }
        } else if (kind == 4 && (PHMASK & 32)) {
            qk_prep(Hb, KC, VC, a.in[7] + l * 128, a.in[8] + l * 128, gw, NGW, lane);
            float* bl = (float*)((char*)lds + 98 * 1024);
            for (int nr = 0; nr < ((PROBE_DUP & 64) ? 2 : 1); ++nr)
            for (int u = blockIdx.x; u < 256; u += G) {
                const int h = u & 7, blk = u >> 3;
                __syncthreads();
                for (int i = tid; i < 465; i += 512) bl[i] = a.in[6][(size_t)(l * 8 + h) * 465 + i] * (1.0f / att::SCALE);
                const int kr_lo = max(0, 4 * blk - 4), NT = min(12, 128 - kr_lo);
                att::attn_dma<true, 9216>(Hb + (size_t)(blk * 256) * DIN + h * 128, Hb + (size_t)(kr_lo * 64) * DIN + 1024 + h * 128, Hb + (size_t)(kr_lo * 64) * DIN + 2048 + h * 128,
                                          OB + (size_t)(blk * 256) * DM + h * 128, NT, (char*)lds, tid, (float*)(ws + OFF_SS) + (size_t)(blk * 256) * 16 + h, 4 * blk, kr_lo, bl);
            }
        } else if (kind == 5 && (PHMASK & 64)) {
            for (int u = blockIdx.x; u < 256; u += G) {
                const int h = u & 7, qb = u >> 3;
                __syncthreads();
                att::attn_dma<false, 256>(Hb + (size_t)(qb * 256) * DIN + 3072 + h * 128, KC + (size_t)(h >> 2) * SEQ * 128, VC + (size_t)(h >> 2) * SEQ * 128,
                                OB + (size_t)(qb * 256) * DM + 1024 + h * 128, 128, (char*)lds, tid, (float*)(ws + OFF_SS) + (size_t)(qb * 256) * 16 + 8 + h, 0, 0, nullptr);
            }
        } else if (PHMASK & 128) {
            ;
        }
        }
#undef a
    }
}

extern "C" void kernel_launch(void* const* d_in, const int* in_sizes, int n_in, void* d_out, int out_size, void* d_ws, size_t ws_size, hipStream_t stream) {
    static int grid_blocks = 0;
    if (grid_blocks == 0) {
        if (n_in != 18 || in_sizes[0] != SEQ * DM || out_size != SEQ * DM || ws_size < WS_TOTAL) {
            fprintf(stderr, "kernel_launch: unexpected shapes: n_in %d in0 %d out %d ws %zu (need %zu)\n", n_in, n_in > 0 ? in_sizes[0] : -1, out_size, ws_size, (size_t)WS_TOTAL); grid_blocks = -1; return; }
        int dev = 0, cus = 0, per_cu = 0;
        hipGetDevice(&dev);
        hipDeviceGetAttribute(&cus, hipDeviceAttributeMultiprocessorCount, dev);
        if (hipFuncSetAttribute((const void*)fwd_megakernel, hipFuncAttributeMaxDynamicSharedMemorySize, LDS_BYTES) != hipSuccess) { fprintf(stderr, "kernel_launch: hipFuncSetAttribute failed\n"); grid_blocks = -1; return; }
        if (hipOccupancyMaxActiveBlocksPerMultiprocessor(&per_cu, (const void*)fwd_megakernel, 512, LDS_BYTES) != hipSuccess || per_cu < 1) { fprintf(stderr, "kernel_launch: occupancy query gave %d\n", per_cu); per_cu = 1; }
        (void)hipGetLastError();
        grid_blocks = cus * per_cu;
        if (grid_blocks != 256) { fprintf(stderr, "kernel_launch: this kernel needs exactly 256 co-resident workgroups (got %d x %d)\n", cus, per_cu); grid_blocks = -1; return; }
    }
    if (grid_blocks < 0) return;
    if (hipMemsetAsync((char*)d_ws + OFF_BAR, 0, BAR_BYTES, stream) != hipSuccess) { fprintf(stderr, "kernel_launch: memset failed\n"); return; }
    Args a{};
    for (int i = 0; i < 18; ++i) a.in[i] = (const float*)d_in[i];
    a.out = (float*)d_out; a.ws = (unsigned char*)d_ws;
#if MK_PER_PHASE_LAUNCH
    for (int p = 0; p < NPHASE; ++p) { a.ph_lo = p; a.ph_hi = p + 1; hipLaunchKernelGGL(fwd_megakernel, dim3(grid_blocks), dim3(512), LDS_BYTES, stream, a); }
#else
    a.ph_lo = 0; a.ph_hi = NPHASE;
    void* args[] = {&a};
    hipError_t e = hipLaunchCooperativeKernel((void*)fwd_megakernel, dim3(grid_blocks), dim3(512), args, LDS_BYTES, stream);
    if (e != hipSuccess) fprintf(stderr, "cooperative launch failed: %s (grid %d)\n", hipGetErrorString(e), grid_blocks);
#endif
}
```

```cpp
#include <hip/hip_runtime.h>
#include <hip/hip_cooperative_groups.h>
#include <hip/hip_bf16.h>
#include <cstdio>
#include <cstdint>
namespace cg = cooperative_groups;
namespace pg8 {
#define PG8_LAS __attribute__((address_space(3)))
typedef unsigned short bf16_t;
typedef short bf16x8 __attribute__((ext_vector_type(8)));
typedef float f32x4 __attribute__((ext_vector_type(4)));
typedef unsigned u32x4 __attribute__((ext_vector_type(4)));
constexpr int BM = 256, BK = 64, HALF = 128, HTB = HALF * BK * 2  , STAGE_BYTES = 8 * HTB, NXCD = 8, WGM = 8;

__host__ __device__ __forceinline__ int lds_byte(int r, int c) { const int st = (r >> 4) * 2 + (c >> 5), rr = r & 15, cc = c & 31, ob = rr * 64 + cc * 2; return st * 1024 + (ob ^ (((ob >> 9) & 1) << 5)); }
__host__ __device__ __forceinline__ void stage_rc(int b, int& R, int& C) { const int st = b / 1024, sb = b % 1024, swz = sb ^ (((sb >> 9) & 1) << 5); R = (st >> 1) * 16 + swz / 64; C = (st & 1) * 32 + (swz % 64) / 2; }
__host__ __device__ __forceinline__ int perm32(int rho) { const int n = rho >> 4, i = rho & 15; return 8 * (i >> 2) + 4 * n + (i & 3); }

struct Unit { int pm, pn, ah, bh, mk; };
struct Gemm { const bf16_t* A; const bf16_t* Bt; int M, N, K; };

struct StaticOrder {
    int nM, nN, nwg, G, c;
    __host__ __device__ void init(int M, int N, int G_, int c_) { nM = M / BM; nN = N / BM; nwg = nM * nN; G = G_; c = c_; }
    __host__ __device__ bool next(int i, Unit& u) const {
        const long L = (long)i * G + c; if (L >= nwg) return false;
        int wgid = (int)L; { const int q = nwg / NXCD, r = nwg % NXCD, xcd = wgid % NXCD, off = wgid / NXCD; wgid = (xcd < r ? xcd * (q + 1) : r * (q + 1) + (xcd - r) * q) + off; }
        const int nig = WGM * nN, gid = wgid / nig, fm = gid * WGM, gsz = (nM - fm) < WGM ? (nM - fm) : WGM;
        u.pm = fm + ((wgid % nig) % gsz); u.pn = (wgid % nig) / gsz; u.ah = 0; u.bh = 0; u.mk = 15; return true;
    }
    __device__ __forceinline__ void a_ready(const Unit&) const {}
    __device__ __forceinline__ void done(const Unit&) const {}
};
struct TailOrder {
    int nM, nN, nwg, G, c, nfull, rem, S;
    __host__ __device__ void init(int M, int N, int G_, int c_, int maxS) { nM = M / BM; nN = N / BM; nwg = nM * nN; G = G_; c = c_; nfull = (nwg / G) * G; rem = nwg - nfull; S = 1;
        if (rem > 0) { const int q = G / rem; S = q >= 4 ? 4 : (q >= 2 ? 2 : 1); if (S > maxS) S = maxS; } }
    __host__ __device__ bool next(int i, Unit& u) const {
        const long L = (long)i * G + c; int wgid, part = 0;
        if (L < nfull) wgid = (int)L; else { const int sidx = (int)(L - nfull); if (sidx >= rem * S) return false; wgid = nfull + sidx % rem; part = sidx / rem; }
        const bool sub = (L >= nfull) && S > 1;
        { const int q = nwg / NXCD, r = nwg % NXCD, xcd = wgid % NXCD, off = wgid / NXCD; wgid = (xcd < r ? xcd * (q + 1) : r * (q + 1) + (xcd - r) * q) + off; }
        const int nig = WGM * nN, gid = wgid / nig, fm = gid * WGM, gsz = (nM - fm) < WGM ? (nM - fm) : WGM;
        u.pm = fm + ((wgid % nig) % gsz); u.pn = (wgid % nig) / gsz;
        if (!sub) { u.ah = 0; u.bh = 0; u.mk = 15; } else if (S == 2) { u.ah = part; u.bh = 0; u.mk = 3; } else { u.ah = part & 1; u.bh = part >> 1; u.mk = 1; }
        return true;
    }
    __device__ __forceinline__ void a_ready(const Unit&) const {}
    __device__ __forceinline__ void done(const Unit&) const {}
};

__device__ __forceinline__ void store16_wt(void* p, u32x4 v) { asm volatile("global_store_dwordx4 %0, %1, off sc0 sc1\n\ts_nop 1" :: "v"(p), "v"(v) : "memory"); }
__device__ __forceinline__ unsigned cvt_pk_bf16(float lo, float hi) { unsigned r; asm volatile("v_cvt_pk_bf16_f32 %0, %1, %2" : "=v"(r) : "v"(lo), "v"(hi)); return r; }
typedef float f32x2 __attribute__((ext_vector_type(2)));
__device__ __forceinline__ f32x2 gelu_pk(f32x2 v) {
    const f32x2 av = __builtin_elementwise_abs(v), d = av * 0.2316418882f + 1.0f;
    f32x2 t; t.x = __builtin_amdgcn_rcpf(d.x); t.y = __builtin_amdgcn_rcpf(d.y);
    f32x2 q = t * 0.5307027145f + (-0.7265760135f); q = q * t + 0.7107068705f; q = q * t + (-0.142248368f); q = q * t + 0.127414796f; q = q * t;
    const f32x2 s = (v * v) * (-0.72134752044f);
    f32x2 e; e.x = __builtin_amdgcn_exp2f(s.x); e.y = __builtin_amdgcn_exp2f(s.y);
    const f32x2 m = v * (q * e), r = v - m;
    f32x2 o; o.x = v.x < 0.f ? m.x : r.x; o.y = v.y < 0.f ? m.y : r.y; return o;
}

template <int ACT  > struct EpiBf16 {
    static constexpr bool PERM = true, AFTER_DRAIN = false, MID = false; static_assert(ACT == 0 || ACT == 1, "EpiBf16: ACT is 0 (none) or 1 (gelu_pk)");
    bf16_t* O; int ldc; const float* bias; int split_cols; size_t split_stride; float scale0;
    __device__ __forceinline__ void operator()(const f32x4 (&acc)[2][2][4][2], const Unit& u, int wr, int wc, int fr, int fq) const {
        const int row0 = u.pm * BM + u.ah * HALF + wr * 64 + fr; int colt = u.pn * BM + u.bh * HALF; bf16_t* base = O;
        float sc = 1.f; if (split_cols) { const int t = colt / split_cols; base += (size_t)t * split_stride; colt -= t * split_cols; if (t == 0) sc = scale0; }
        const int col0 = colt + wc * 32 + 8 * fq, bcol0 = u.pn * BM + wc * 32 + 8 * fq;
        f32x4 bv[2][2];
#pragma unroll
        for (int bj = 0; bj < 2; ++bj)
#pragma unroll
            for (int n = 0; n < 2; ++n) bv[bj][n] = bias ? *(const f32x4*)(bias + bcol0 + bj * HALF + 4 * n) : (f32x4){0.f, 0.f, 0.f, 0.f};
#pragma unroll
        for (int ai = 0; ai < 2; ++ai)
#pragma unroll
            for (int m = 0; m < 4; ++m) { bf16_t* rowp = base + (size_t)(row0 + ai * HALF + m * 16) * ldc + col0;
#pragma unroll
                for (int bj = 0; bj < 2; ++bj) { if (!((u.mk >> (2 * ai + bj)) & 1)) continue; f32x4 v0 = acc[ai][bj][m][0] + bv[bj][0], v1 = acc[ai][bj][m][1] + bv[bj][1];
                    if (ACT == 1) { f32x2 a = gelu_pk((f32x2){v0[0], v0[1]}), b = gelu_pk((f32x2){v0[2], v0[3]}), c = gelu_pk((f32x2){v1[0], v1[1]}), d = gelu_pk((f32x2){v1[2], v1[3]});
                        v0 = (f32x4){a.x, a.y, b.x, b.y}; v1 = (f32x4){c.x, c.y, d.x, d.y}; }
                    v0 = v0 * sc; v1 = v1 * sc; u32x4 w; w.x = cvt_pk_bf16(v0[0], v0[1]); w.y = cvt_pk_bf16(v0[2], v0[3]); w.z = cvt_pk_bf16(v1[0], v1[1]); w.w = cvt_pk_bf16(v1[2], v1[3]);
                    *(u32x4*)(rowp + bj * HALF) = w; } }
    }
};
struct EpiSwiGLU {
    static constexpr bool PERM = true, AFTER_DRAIN = false, MID = false;
    bf16_t* O; int ldc;
    __device__ __forceinline__ void operator()(const f32x4 (&acc)[2][2][4][2], const Unit& u, int wr, int wc, int fr, int fq) const {
        const int row0 = u.pm * BM + u.ah * HALF + wr * 64 + fr; const int col0 = u.pn * HALF + wc * 32 + 8 * fq;
#pragma unroll
        for (int ai = 0; ai < 2; ++ai)
#pragma unroll
            for (int m = 0; m < 4; ++m) { if (!((u.mk >> (2 * ai)) & 1)) continue; bf16_t* rowp = O + (size_t)(row0 + ai * HALF + m * 16) * ldc + col0;
                float h[8];
#pragma unroll
                for (int n = 0; n < 2; ++n)
#pragma unroll
                    for (int e = 0; e < 4; ++e) { const float g = acc[ai][0][m][n][e], up = acc[ai][1][m][n][e];
                        const float s = __builtin_amdgcn_rcpf(1.0f + __builtin_amdgcn_exp2f(-1.4426950408889634f * g));
                        h[n * 4 + e] = g * s * up; }
                u32x4 w; w.x = cvt_pk_bf16(h[0], h[1]); w.y = cvt_pk_bf16(h[2], h[3]); w.z = cvt_pk_bf16(h[4], h[5]); w.w = cvt_pk_bf16(h[6], h[7]);
                *(u32x4*)rowp = w; }
    }
};
struct EpiResid {
    static constexpr bool PERM = false, AFTER_DRAIN = false, MID = false;
    const float* base; float* out; int ldc; float sa, sb;
    __device__ __forceinline__ void operator()(const f32x4 (&acc)[2][2][4][2], const Unit& u, int wr, int wc, int fr, int fq) const {
        const int col0 = u.pn * BM + wc * 32 + 4 * fq;
#pragma unroll
        for (int ai = 0; ai < 2; ++ai)
#pragma unroll
            for (int m = 0; m < 4; ++m) { const size_t off = (size_t)(u.pm * BM + ai * HALF + wr * 64 + m * 16 + fr) * ldc + col0;
#pragma unroll
                for (int bj = 0; bj < 2; ++bj)
#pragma unroll
                    for (int n = 0; n < 2; ++n) { const f32x4 bs = *(const f32x4*)(base + off + bj * HALF + n * 16);
                        *(f32x4*)(out + off + bj * HALF + n * 16) = bs * sa + acc[ai][bj][m][n] * sb; } }
    }
};
__device__ __forceinline__ float xshfl(float v, int o, int lane) { return __int_as_float(__builtin_amdgcn_ds_bpermute((lane ^ o) << 2, __float_as_int(v))); }
struct PanelStats8 {
    unsigned long long* xbuf;
    unsigned* cnt;
    float eps;
    __device__ __forceinline__ void run(const f32x4 (&v)[2][2][4][2], const Unit& u, int wr, int wc, int fr, int fq, PG8_LAS unsigned char* lds, int wid, int lane) const {
        typedef float f32x2v __attribute__((ext_vector_type(2)));
        PG8_LAS f32x2v* P = (PG8_LAS f32x2v*)lds;
        PG8_LAS f32x2v* S = (PG8_LAS f32x2v*)(lds + 8192);
#pragma unroll
        for (int ai = 0; ai < 2; ++ai)
#pragma unroll
            for (int m = 0; m < 4; ++m) {
                float s = 0.f;
#pragma unroll
                for (int bj = 0; bj < 2; ++bj)
#pragma unroll
                    for (int n = 0; n < 2; ++n) { const f32x4 x = v[ai][bj][m][n]; s += (x[0] + x[1]) + (x[2] + x[3]); }
                s += xshfl(s, 16, lane); s += xshfl(s, 32, lane);
                const float mw = s * (1.0f / 64.0f); float q = 0.f;
#pragma unroll
                for (int bj = 0; bj < 2; ++bj)
#pragma unroll
                    for (int n = 0; n < 2; ++n) { const f32x4 d = v[ai][bj][m][n] - mw; q += (d[0] * d[0] + d[1] * d[1]) + (d[2] * d[2] + d[3] * d[3]); }
                q += xshfl(q, 16, lane); q += xshfl(q, 32, lane);
                if (fq == 0) P[(ai * HALF + wr * 64 + m * 16 + fr) * 4 + wc] = (f32x2v){mw, q};
            }
        asm volatile("s_waitcnt lgkmcnt(0)" ::: "memory"); __builtin_amdgcn_s_barrier(); asm volatile("" ::: "memory");
        const int row = wid * 32 + (lane & 31);
        if (lane < 32) {
            const f32x2v a = P[row * 4 + 0], b = P[row * 4 + 1], c = P[row * 4 + 2], d = P[row * 4 + 3];
            const float mt = (a.x + b.x + c.x + d.x) * 0.25f;
            const float da = a.x - mt, db = b.x - mt, dc = c.x - mt, dd = d.x - mt;
            const float m2 = (a.y + b.y) + (c.y + d.y) + 64.0f * ((da * da + db * db) + (dc * dc + dd * dd));
            unsigned long long* slot = xbuf + ((size_t)(u.pm * BM + row) * 8 + u.pn);
            __hip_atomic_store(slot, ((unsigned long long)__float_as_uint(m2) << 32) | __float_as_uint(mt), __ATOMIC_RELAXED, __HIP_MEMORY_SCOPE_AGENT);
        }
        asm volatile("s_waitcnt vmcnt(0)" ::: "memory");
        if (lane == 0) __hip_atomic_fetch_add(cnt + 64 * u.pm, 1u, __ATOMIC_RELAXED, __HIP_MEMORY_SCOPE_AGENT);
        if (wid == 0) {
            unsigned sp = 0;
            for (;;) {
                if ((unsigned)__builtin_amdgcn_readfirstlane(__hip_atomic_load(cnt + 64 * u.pm, __ATOMIC_RELAXED, __HIP_MEMORY_SCOPE_AGENT)) >= 64u) break;
                if (++sp > (1u << 22)) break;
                __builtin_amdgcn_s_sleep(2);
            }
            __builtin_amdgcn_fence(__ATOMIC_ACQUIRE, "agent");
        }
        asm volatile("s_waitcnt vmcnt(0) lgkmcnt(0)" ::: "memory"); __builtin_amdgcn_s_barrier(); asm volatile("" ::: "memory");
        if (lane < 32) {
            const unsigned long long* slot = xbuf + (size_t)(u.pm * BM + row) * 8; float mt[8], m2[8]; float ms = 0.f;
#pragma unroll
            for (int t = 0; t < 8; ++t) { const unsigned long long w = __hip_atomic_load(slot + t, __ATOMIC_RELAXED, __HIP_MEMORY_SCOPE_AGENT); mt[t] = __uint_as_float((unsigned)w); m2[t] = __uint_as_float((unsigned)(w >> 32)); ms += mt[t]; }
            const float mean = ms * 0.125f; float q = 0.f;
#pragma unroll
            for (int t = 0; t < 8; ++t) { const float dm = mt[t] - mean; q += m2[t] + 256.0f * dm * dm; }
            S[row] = (f32x2v){mean, 1.0f / sqrtf(q * (1.0f / 2048.0f) + eps)};
        }
        asm volatile("s_waitcnt lgkmcnt(0)" ::: "memory"); __builtin_amdgcn_s_barrier(); asm volatile("" ::: "memory");
    }
};
struct EpiResidLn {
    static constexpr bool PERM = true, AFTER_DRAIN = true, MID = true;
    const bf16_t* base; float* out; bf16_t* outb; int ldc; float sa, sb; const float* g; const float* b; PanelStats8 st; const PG8_LAS float* rs; int use_rs;
    __device__ __forceinline__ void mid(f32x4 (&acc)[2][2][4][2], const Unit& u, int wr, int fr) const {
        const PG8_LAS float* rp = rs + 2 * (wr * 64 + fr);
#pragma unroll
        for (int ai = 0; ai < 2; ++ai)
#pragma unroll
            for (int m = 0; m < 4; ++m) { const float r = rp[2 * (ai * HALF + m * 16)];
#pragma unroll
                for (int bj = 0; bj < 2; ++bj)
#pragma unroll
                    for (int n = 0; n < 2; ++n) acc[ai][bj][m][n] *= r; }
    }
    __device__ __forceinline__ void operator()(const f32x4 (&)[2][2][4][2], const Unit&, int, int, int, int) const {}
    __device__ __forceinline__ void fused(f32x4 (&acc)[2][2][4][2], const Unit& u, int wr, int wc, int fr, int fq, PG8_LAS unsigned char* lds, int wid, int lane) const {
        typedef float f32x2v __attribute__((ext_vector_type(2)));
        const PG8_LAS f32x2v* S = (const PG8_LAS f32x2v*)(lds + 8192);
        const int col0 = u.pn * BM + wc * 32 + 8 * fq;
        u32x4 bw[2][4][2];
#pragma unroll
        for (int ai = 0; ai < 2; ++ai)
#pragma unroll
            for (int m = 0; m < 4; ++m) { const size_t off = (size_t)(u.pm * BM + ai * HALF + wr * 64 + m * 16 + fr) * ldc + col0;
#pragma unroll
                for (int bj = 0; bj < 2; ++bj) bw[ai][m][bj] = *(const u32x4*)(base + off + bj * HALF); }
#pragma unroll
        for (int ai = 0; ai < 2; ++ai)
#pragma unroll
            for (int m = 0; m < 4; ++m) {
                float sbr = 0.5f; if (use_rs) sbr = rs[2 * (wr * 64 + fr) + 2 * (ai * HALF + m * 16) + 1];
#pragma unroll
                for (int bj = 0; bj < 2; ++bj)
#pragma unroll
                    for (int n = 0; n < 2; ++n) { const unsigned w0 = bw[ai][m][bj][2 * n], w1 = bw[ai][m][bj][2 * n + 1];
                        const f32x4 bs = {__uint_as_float(w0 << 16), __uint_as_float(w0 & 0xffff0000u), __uint_as_float(w1 << 16), __uint_as_float(w1 & 0xffff0000u)};
                        acc[ai][bj][m][n] = bs * 1.4142135623730951f + acc[ai][bj][m][n] * sbr; } }
        st.run(acc, u, wr, wc, fr, fq, lds, wid, lane);
        f32x4 gv[2][2], bv[2][2];
#pragma unroll
        for (int bj = 0; bj < 2; ++bj)
#pragma unroll
            for (int n = 0; n < 2; ++n) { gv[bj][n] = *(const f32x4*)(g + col0 + bj * HALF + n * 4); bv[bj][n] = *(const f32x4*)(b + col0 + bj * HALF + n * 4); }
#pragma unroll
        for (int ai = 0; ai < 2; ++ai)
#pragma unroll
            for (int m = 0; m < 4; ++m) { const int r = ai * HALF + wr * 64 + m * 16 + fr; const f32x2v sr = S[r]; const size_t off = (size_t)(u.pm * BM + r) * ldc + col0;
#pragma unroll
                for (int bj = 0; bj < 2; ++bj) {
                    const f32x4 o0 = (acc[ai][bj][m][0] - sr.x) * sr.y * gv[bj][0] + bv[bj][0], o1 = (acc[ai][bj][m][1] - sr.x) * sr.y * gv[bj][1] + bv[bj][1];
                    if (out) { *(f32x4*)(out + off + bj * HALF) = o0; *(f32x4*)(out + off + bj * HALF + 4) = o1; }
                    else { u32x4 w; w.x = cvt_pk_bf16(o0[0], o0[1]); w.y = cvt_pk_bf16(o0[2], o0[3]); w.z = cvt_pk_bf16(o1[0], o1[1]); w.w = cvt_pk_bf16(o1[2], o1[3]); store16_wt(outb + off + bj * HALF, w); } }
            }
    }
};
template <class Epi, class Sched, bool ALIGN_EPI = false, bool SP2 = false>
__device__ __forceinline__ void gemm_phase(PG8_LAS unsigned char* lds, const Gemm g, const Sched& S, const Epi& E, const int tid) {
    const int wid = __builtin_amdgcn_readfirstlane(tid >> 6), lane = tid & 63, wr = wid >> 2, wc = wid & 3, fr = lane & 15, fq = lane >> 4;
    const int K = g.K, nt = K / BK;
    unsigned voffA[2], voffB[2];
#pragma unroll
    for (int i = 0; i < 2; ++i) { int R, C; stage_rc(tid * 16 + i * 8192, R, C); const int Rb = Epi::PERM ? ((R & ~31) + perm32(R & 31)) : R;
        voffA[i] = (unsigned)(R * K + C) * 2u; voffB[i] = (unsigned)(Rb * K + C) * 2u; }
    const size_t kstep = (size_t)(BK * 2);
    const size_t hstep = (size_t)HALF * K * 2;
    const size_t tstep = 2 * hstep;
    const unsigned ldsw = (unsigned)wid * 1024u;
    const int aoff = lds_byte(wr * 64 + fr, fq * 8), boff = lds_byte(wc * 32 + fr, fq * 8);
#define PG8_SA(b, h) (((b) * 2 + (h)) * HTB)
#define PG8_SB(b, h) ((4 + (b) * 2 + (h)) * HTB)
#define PG8_STAGE(bufoff, gbase, voff) do { _Pragma("unroll") for (int _i = 0; _i < 2; ++_i) \
        __builtin_amdgcn_global_load_lds((const unsigned*)((const char*)(gbase) + (voff)[_i]), (PG8_LAS unsigned*)(lds + (bufoff) + ldsw + _i * 8192), 16, 0, 0); } while (0)
#define PG8_LDA(dst, b, h) do { if (PG8_MSK && !(mk & (3 << (2 * (h))))) break; _Pragma("unroll") for (int m = 0; m < 4; ++m) _Pragma("unroll") for (int k = 0; k < 2; ++k) dst[m][k] = *(const PG8_LAS bf16x8*)(lds + PG8_SA(b, h) + aoff + m * 2048 + k * 1024); } while (0)
#define PG8_LDB(dst, b, h) do { if (PG8_MSK && !(mk & (5 << (h)))) break; _Pragma("unroll") for (int n = 0; n < 2; ++n) _Pragma("unroll") for (int k = 0; k < 2; ++k) dst[n][k] = *(const PG8_LAS bf16x8*)(lds + PG8_SB(b, h) + boff + n * 2048 + k * 1024); } while (0)
#define PG8_MMA(ai, bj, At, Bt) do { if (PG8_MSK && !((mk >> (2 * (ai) + (bj))) & 1)) break; __builtin_amdgcn_s_setprio(1); _Pragma("unroll") for (int m = 0; m < 4; ++m) _Pragma("unroll") for (int n = 0; n < 2; ++n) _Pragma("unroll") for (int k = 0; k < 2; ++k) \
        acc[ai][bj][m][n] = __builtin_amdgcn_mfma_f32_16x16x32_bf16(Bt[n][k], At[m][k], acc[ai][bj][m][n], 0, 0, 0); __builtin_amdgcn_s_setprio(0); } while (0)
#define PG8_WAIT_V(n) asm volatile("s_waitcnt vmcnt(" #n ")" ::: "memory")
#define PG8_WAIT_L(n) asm volatile("s_waitcnt lgkmcnt(" #n ")" ::: "memory")
#define PG8_BAR __builtin_amdgcn_s_barrier()
#define PG8_SCHED __builtin_amdgcn_sched_barrier(0)
    Unit cur, nxt; int ui = 0;
    if (!S.next(0, cur)) return;
    f32x4 acc[2][2][4][2];
#pragma unroll
    for (int a = 0; a < 2; ++a)
#pragma unroll
        for (int b = 0; b < 2; ++b)
#pragma unroll
            for (int m = 0; m < 4; ++m)
#pragma unroll
                for (int n = 0; n < 2; ++n) acc[a][b][m][n] = (f32x4){0.f, 0.f, 0.f, 0.f};
    bf16x8 At[4][2], B0[2][2], B1[2][2];
    const char* cA = (const char*)g.A + (size_t)cur.pm * tstep + (size_t)cur.ah * hstep; const char* cB = (const char*)g.Bt + (size_t)cur.pn * tstep + (size_t)cur.bh * hstep;
    S.a_ready(cur);
    if constexpr (SP2) {
        PG8_STAGE(PG8_SB(0, 0), cB, voffB); PG8_STAGE(PG8_SB(0, 1), cB + hstep, voffB); PG8_STAGE(PG8_SA(0, 0), cA, voffA); PG8_STAGE(PG8_SA(0, 1), cA + hstep, voffA);
        if (wr == 1) PG8_BAR;
        PG8_WAIT_V(2); PG8_BAR;
        PG8_STAGE(PG8_SB(1, 0), cB + kstep, voffB); PG8_STAGE(PG8_SA(1, 0), cA + kstep, voffA); PG8_STAGE(PG8_SB(1, 1), cB + hstep + kstep, voffB);
        PG8_WAIT_V(6); PG8_BAR;
    } else {
        PG8_STAGE(PG8_SB(0, 0), cB, voffB); PG8_STAGE(PG8_SA(0, 0), cA, voffA); PG8_STAGE(PG8_SB(0, 1), cB + hstep, voffB); PG8_STAGE(PG8_SA(0, 1), cA + hstep, voffA);
        if (wr == 1) PG8_BAR;
        PG8_WAIT_V(4); PG8_BAR;
        PG8_STAGE(PG8_SB(1, 0), cB + kstep, voffB); PG8_STAGE(PG8_SA(1, 0), cA + kstep, voffA); PG8_STAGE(PG8_SB(1, 1), cB + hstep + kstep, voffB);
        PG8_WAIT_V(6); PG8_BAR;
    }
    for (;;) {
        const bool has_next = S.next(ui + 1, nxt);
        const char* nA = has_next ? (const char*)g.A + (size_t)nxt.pm * tstep + (size_t)nxt.ah * hstep : cA; const char* nB = has_next ? (const char*)g.Bt + (size_t)nxt.pn * tstep + (size_t)nxt.bh * hstep : cB;
        const int mk = cur.mk;
        if (mk == 15) {
#define PG8_MSK 0
        for (int t = 0; t < nt; t += 2) {
            const bool last = (t == nt - 2);
            if constexpr (Epi::MID) { if (E.use_rs && t == (nt >> 1)) E.mid(acc, cur, wr, fr); }
            const char* a1 = cA + (size_t)(t + 1) * kstep;
            const char* a2 = last ? nA : cA + (size_t)(t + 2) * kstep; const char* b2 = last ? nB : cB + (size_t)(t + 2) * kstep;
            const char* a3 = a2 + kstep; const char* b3 = b2 + kstep;
            if (last && has_next) S.a_ready(nxt);
            if constexpr (SP2) {
            PG8_LDB(B0, 0, 0); PG8_LDB(B1, 0, 1); PG8_SCHED; PG8_LDA(At, 0, 0); PG8_STAGE(PG8_SA(1, 1), a1 + hstep, voffA);
            PG8_WAIT_V(8); PG8_WAIT_L(0); PG8_BAR; PG8_MMA(0, 0, At, B0); PG8_MMA(0, 1, At, B1); PG8_BAR; PG8_SCHED;
            PG8_LDA(At, 0, 1); PG8_STAGE(PG8_SB(0, 0), b2, voffB); PG8_STAGE(PG8_SB(0, 1), b2 + hstep, voffB); PG8_STAGE(PG8_SA(0, 0), a2, voffA);
            PG8_WAIT_V(8); PG8_WAIT_L(0); PG8_BAR; PG8_MMA(1, 0, At, B0); PG8_MMA(1, 1, At, B1); PG8_BAR; PG8_SCHED;
            PG8_LDB(B0, 1, 0); PG8_LDB(B1, 1, 1); PG8_SCHED; PG8_LDA(At, 1, 0); PG8_STAGE(PG8_SA(0, 1), a2 + hstep, voffA);
            PG8_WAIT_V(8); PG8_WAIT_L(0); PG8_BAR; PG8_MMA(0, 0, At, B0); PG8_MMA(0, 1, At, B1); PG8_BAR; PG8_SCHED;
            PG8_LDA(At, 1, 1); PG8_STAGE(PG8_SB(1, 0), b3, voffB); PG8_STAGE(PG8_SB(1, 1), b3 + hstep, voffB); PG8_STAGE(PG8_SA(1, 0), a3, voffA);
            PG8_WAIT_V(8); PG8_WAIT_L(0); PG8_BAR; PG8_MMA(1, 0, At, B0); PG8_MMA(1, 1, At, B1); PG8_BAR; PG8_SCHED;
            } else {
            PG8_LDB(B0, 0, 0); PG8_SCHED; PG8_LDA(At, 0, 0); PG8_STAGE(PG8_SA(1, 1), a1 + hstep, voffA);
            PG8_WAIT_L(8); PG8_BAR; PG8_WAIT_L(0); PG8_MMA(0, 0, At, B0); PG8_BAR; PG8_SCHED;
            PG8_LDB(B1, 0, 1); PG8_STAGE(PG8_SB(0, 0), b2, voffB);
            PG8_BAR; PG8_WAIT_L(0); PG8_MMA(0, 1, At, B1); PG8_BAR;
            PG8_LDA(At, 0, 1); PG8_STAGE(PG8_SA(0, 0), a2, voffA);
            PG8_BAR; PG8_WAIT_L(0); PG8_MMA(1, 0, At, B0); PG8_BAR; PG8_SCHED;
            PG8_STAGE(PG8_SB(0, 1), b2 + hstep, voffB);
            PG8_WAIT_V(6); PG8_BAR; PG8_MMA(1, 1, At, B1); PG8_BAR;
            PG8_LDB(B0, 1, 0); PG8_SCHED; PG8_LDA(At, 1, 0); PG8_STAGE(PG8_SA(0, 1), a2 + hstep, voffA);
            PG8_WAIT_L(8); PG8_BAR; PG8_WAIT_L(0); PG8_MMA(0, 0, At, B0); PG8_BAR; PG8_SCHED;
            PG8_LDB(B1, 1, 1); PG8_STAGE(PG8_SB(1, 0), b3, voffB);
            PG8_BAR; PG8_WAIT_L(0); PG8_MMA(0, 1, At, B1); PG8_BAR;
            PG8_LDA(At, 1, 1); PG8_STAGE(PG8_SA(1, 0), a3, voffA);
            PG8_BAR; PG8_WAIT_L(0); PG8_MMA(1, 0, At, B0); PG8_BAR; PG8_SCHED;
            PG8_STAGE(PG8_SB(1, 1), b3 + hstep, voffB);
            PG8_WAIT_V(6); PG8_BAR; PG8_MMA(1, 1, At, B1); PG8_BAR;
            }
        }
#undef PG8_MSK
        } else {
#define PG8_MSK 1
        for (int t = 0; t < nt; t += 2) {
            const bool last = (t == nt - 2);
            if constexpr (Epi::MID) { if (E.use_rs && t == (nt >> 1)) E.mid(acc, cur, wr, fr); }
            const char* a1 = cA + (size_t)(t + 1) * kstep;
            const char* a2 = last ? nA : cA + (size_t)(t + 2) * kstep; const char* b2 = last ? nB : cB + (size_t)(t + 2) * kstep;
            const char* a3 = a2 + kstep; const char* b3 = b2 + kstep;
            if (last && has_next) S.a_ready(nxt);
            if constexpr (SP2) {
            PG8_LDB(B0, 0, 0); PG8_LDB(B1, 0, 1); PG8_SCHED; PG8_LDA(At, 0, 0); PG8_STAGE(PG8_SA(1, 1), a1 + hstep, voffA);
            PG8_WAIT_V(8); PG8_WAIT_L(0); PG8_BAR; PG8_MMA(0, 0, At, B0); PG8_MMA(0, 1, At, B1); PG8_BAR; PG8_SCHED;
            PG8_LDA(At, 0, 1); PG8_STAGE(PG8_SB(0, 0), b2, voffB); PG8_STAGE(PG8_SB(0, 1), b2 + hstep, voffB); PG8_STAGE(PG8_SA(0, 0), a2, voffA);
            PG8_WAIT_V(8); PG8_WAIT_L(0); PG8_BAR; PG8_MMA(1, 0, At, B0); PG8_MMA(1, 1, At, B1); PG8_BAR; PG8_SCHED;
            PG8_LDB(B0, 1, 0); PG8_LDB(B1, 1, 1); PG8_SCHED; PG8_LDA(At, 1, 0); PG8_STAGE(PG8_SA(0, 1), a2 + hstep, voffA);
            PG8_WAIT_V(8); PG8_WAIT_L(0); PG8_BAR; PG8_MMA(0, 0, At, B0); PG8_MMA(0, 1, At, B1); PG8_BAR; PG8_SCHED;
            PG8_LDA(At, 1, 1); PG8_STAGE(PG8_SB(1, 0), b3, voffB); PG8_STAGE(PG8_SB(1, 1), b3 + hstep, voffB); PG8_STAGE(PG8_SA(1, 0), a3, voffA);
            PG8_WAIT_V(8); PG8_WAIT_L(0); PG8_BAR; PG8_MMA(1, 0, At, B0); PG8_MMA(1, 1, At, B1); PG8_BAR; PG8_SCHED;
            } else {
            PG8_LDB(B0, 0, 0); PG8_SCHED; PG8_LDA(At, 0, 0); PG8_STAGE(PG8_SA(1, 1), a1 + hstep, voffA);
            PG8_WAIT_L(8); PG8_BAR; PG8_WAIT_L(0); PG8_MMA(0, 0, At, B0); PG8_BAR; PG8_SCHED;
            PG8_LDB(B1, 0, 1); PG8_STAGE(PG8_SB(0, 0), b2, voffB);
            PG8_BAR; PG8_WAIT_L(0); PG8_MMA(0, 1, At, B1); PG8_BAR;
            PG8_LDA(At, 0, 1); PG8_STAGE(PG8_SA(0, 0), a2, voffA);
            PG8_BAR; PG8_WAIT_L(0); PG8_MMA(1, 0, At, B0); PG8_BAR; PG8_SCHED;
            PG8_STAGE(PG8_SB(0, 1), b2 + hstep, voffB);
            PG8_WAIT_V(6); PG8_BAR; PG8_MMA(1, 1, At, B1); PG8_BAR;
            PG8_LDB(B0, 1, 0); PG8_SCHED; PG8_LDA(At, 1, 0); PG8_STAGE(PG8_SA(0, 1), a2 + hstep, voffA);
            PG8_WAIT_L(8); PG8_BAR; PG8_WAIT_L(0); PG8_MMA(0, 0, At, B0); PG8_BAR; PG8_SCHED;
            PG8_LDB(B1, 1, 1); PG8_STAGE(PG8_SB(1, 0), b3, voffB);
            PG8_BAR; PG8_WAIT_L(0); PG8_MMA(0, 1, At, B1); PG8_BAR;
            PG8_LDA(At, 1, 1); PG8_STAGE(PG8_SA(1, 0), a3, voffA);
            PG8_BAR; PG8_WAIT_L(0); PG8_MMA(1, 0, At, B0); PG8_BAR; PG8_SCHED;
            PG8_STAGE(PG8_SB(1, 1), b3 + hstep, voffB);
            PG8_WAIT_V(6); PG8_BAR; PG8_MMA(1, 1, At, B1); PG8_BAR;
            }
        }
#undef PG8_MSK
        }
        if constexpr (ALIGN_EPI) { if (wr == 0) PG8_BAR; }
        if constexpr (!Epi::AFTER_DRAIN) { E(acc, cur, wr, wc, fr, fq); S.done(cur); }
        if (!has_next) break;
#pragma unroll
        for (int a = 0; a < 2; ++a)
#pragma unroll
            for (int b = 0; b < 2; ++b)
#pragma unroll
                for (int m = 0; m < 4; ++m)
#pragma unroll
                    for (int n = 0; n < 2; ++n) acc[a][b][m][n] = (f32x4){0.f, 0.f, 0.f, 0.f};
        cur = nxt; cA = nA; cB = nB; ++ui;
        if constexpr (ALIGN_EPI) { if (wr == 1) PG8_BAR; }
    }
    PG8_WAIT_V(0);
    if constexpr (!ALIGN_EPI) { if (wr == 0) PG8_BAR; }
    PG8_BAR;
    if constexpr (Epi::AFTER_DRAIN) { E.fused(acc, cur, wr, wc, fr, fq, lds, wid, lane); S.done(cur); }
#undef PG8_SA
#undef PG8_SB
#undef PG8_STAGE
#undef PG8_LDA
#undef PG8_LDB
#undef PG8_MMA
#undef PG8_WAIT_V
#undef PG8_WAIT_L
#undef PG8_BAR
#undef PG8_SCHED
}
}
namespace att {
using bf16 = unsigned short;
constexpr int D = 128, NW = 8, QBLK = 32, KVBLK = 64;
constexpr float SCALE = 0.088388347648318440f;
constexpr float THR = 8.f;
constexpr int LDQ = 4608, LDK = 4608, LDO = 2048;
constexpr size_t SHM_V = KVBLK * D * 2, SHM_K = KVBLK * D * 2, SHM_ATTN = 2 * SHM_V + 2 * SHM_K + NW * 64 * 4;
constexpr int BIAS_OFF = 68 * 1024, QLDS_OFF = 72 * 1024;
using bf16x8 = __attribute__((ext_vector_type(8))) short;
using s16x4  = __attribute__((ext_vector_type(4))) short;
using f32x16 = __attribute__((ext_vector_type(16))) float;
using u32x4  = __attribute__((ext_vector_type(4))) unsigned;
#define KSWZ(row, colB) ((row) * 256 + ((colB) ^ (((row) & 7) << 4)))
#define SBAR() __builtin_amdgcn_sched_barrier(0)
__device__ __forceinline__ int crow(int r, int hi) { return (r & 3) + 8 * (r >> 2) + 4 * hi; }
__device__ __forceinline__ unsigned cvtpk(float lo, float hi) {
  unsigned r; asm volatile("v_cvt_pk_bf16_f32 %0, %1, %2" : "=v"(r) : "v"(lo), "v"(hi)); return r;
}
__device__ __forceinline__ float xs(float v, int o, int lane) { return __int_as_float(__builtin_amdgcn_ds_bpermute((lane ^ o) << 2, __float_as_int(v))); }
__device__ __forceinline__ float sumsq8(u32x4 w) { float q = 0.f;
#pragma unroll
  for (int e = 0; e < 4; ++e) { const float lo = __uint_as_float(w[e] << 16), hi = __uint_as_float(w[e] & 0xffff0000u); q += lo * lo + hi * hi; } return q; }
__device__ __forceinline__ void st16_wt(void* p, u32x4 v) { asm volatile("global_store_dwordx4 %0, %1, off sc0 sc1\n\ts_nop 1" :: "v"(p), "v"(v) : "memory"); }
__device__ __forceinline__ void partialSM(f32x16& p0, f32x16& p1, float& m_reg, float& mn, float& alpha) {
  constexpr float C = SCALE * 1.4426950408889634f;
  float pmax = p0[0]; for (int r = 1; r < 16; ++r) pmax = fmaxf(pmax, p0[r]); for (int r = 0; r < 16; ++r) pmax = fmaxf(pmax, p1[r]);
  { auto rr = __builtin_amdgcn_permlane32_swap(__float_as_uint(pmax), __float_as_uint(pmax), false, false);
    pmax = fmaxf(__uint_as_float(rr[0]), __uint_as_float(rr[1])); }
  if (__builtin_expect(__all(pmax - m_reg <= THR / SCALE), 1)) { mn = m_reg; alpha = 1.f; }
  else { mn = fmaxf(m_reg, pmax); alpha = __builtin_amdgcn_exp2f((m_reg - mn) * C); m_reg = mn; }
  float mnC = -mn * C;
  for (int r = 0; r < 16; ++r) p0[r] = fmaf(p0[r], C, mnC); for (int r = 0; r < 16; ++r) p1[r] = fmaf(p1[r], C, mnC);
  for (int r = 0; r < 16; ++r) p0[r] = __builtin_amdgcn_exp2f(p0[r]);
}
__device__ __forceinline__ void finishSM(f32x16& p0, f32x16& p1, float alpha, float& l_reg, bf16x8& pa0, bf16x8& pa1, bf16x8& pa2, bf16x8& pa3) {
  for (int r = 0; r < 16; ++r) p1[r] = __builtin_amdgcn_exp2f(p1[r]);
  float ps = 0; for (int r = 0; r < 16; ++r) ps += p0[r]; for (int r = 0; r < 16; ++r) ps += p1[r];
  { auto rr = __builtin_amdgcn_permlane32_swap(__float_as_uint(ps), __float_as_uint(ps), false, false);
    ps = __uint_as_float(rr[0]) + __uint_as_float(rr[1]); }
  l_reg = l_reg * alpha + ps;
#define PK4(P, BASE, OUT) do { unsigned a0 = cvtpk(P[BASE + 0], P[BASE + 1]), a1 = cvtpk(P[BASE + 2], P[BASE + 3]);   \
    unsigned b0 = cvtpk(P[BASE + 4], P[BASE + 5]), b1 = cvtpk(P[BASE + 6], P[BASE + 7]);                              \
    auto r0 = __builtin_amdgcn_permlane32_swap(a0, b0, false, false); auto r1 = __builtin_amdgcn_permlane32_swap(a1, b1, false, false); \
    u32x4 w = {r0[0], r1[0], r0[1], r1[1]}; OUT = *reinterpret_cast<bf16x8*>(&w); } while (0)
  PK4(p0, 0, pa0); PK4(p0, 8, pa1); PK4(p1, 0, pa2); PK4(p1, 8, pa3);
#undef PK4
}
template <bool QL>
__device__ __forceinline__ void qkt(f32x16& p0, f32x16& p1, const bf16* Ks, const bf16x8* qr, const char* ql, int r32, int hi) {
  p0 = f32x16{}; p1 = f32x16{};
  for (int d0 = 0; d0 < 8; ++d0) { int cb = (d0 * 16 + hi * 8) * 2;
    bf16x8 b0 = *reinterpret_cast<const bf16x8*>((const char*)Ks + KSWZ(r32, cb));
    bf16x8 b1 = *reinterpret_cast<const bf16x8*>((const char*)Ks + KSWZ(32 + r32, cb));
    bf16x8 q; if constexpr (QL) q = *reinterpret_cast<const bf16x8*>(ql + d0 * 1024); else q = qr[d0];
    p0 = __builtin_amdgcn_mfma_f32_32x32x16_bf16(b0, q, p0, 0, 0, 0);
    p1 = __builtin_amdgcn_mfma_f32_32x32x16_bf16(b1, q, p1, 0, 0, 0); }
}
__device__ __forceinline__ void na_mask(f32x16& p0, f32x16& p1, int kr, int r0, int qrow, int qc, int c0, int hi, const float* bl) {
  const bool tv = (kr >= r0) && (kr < r0 + 8);
  if (!tv) {
#pragma unroll
    for (int r = 0; r < 16; ++r) { p0[r] = -1e30f; p1[r] = -1e30f; }
  } else {
    const float* brow = bl + (kr - qrow + 7) * 31 + 15 - qc + 4 * hi;
    const int d = 4 * hi - c0;
#pragma unroll
    for (int r = 0; r < 16; ++r) {
      const int kc = (r & 3) + 8 * (r >> 2);
      const float b0 = brow[kc], b1 = brow[kc + 32];
      p0[r] = (unsigned)(d + kc) < 16u ? p0[r] + b0 : -1e30f; p1[r] = (unsigned)(d + kc + 32) < 16u ? p1[r] + b1 : -1e30f;
    }
  }
}
__device__ __forceinline__ int v_st(int k, int c) { const int kk = (k & ~0xC) | ((k & 4) << 1) | ((k & 8) >> 1); return ((kk >> 3) * 4 + (c >> 5)) * 512 + ((kk & 7) * 32 + (c & 31)) * 2; }
__device__ __forceinline__ int v_rd_base(int lane) { return ((lane & 3) << 3) | (((lane >> 2) & 3) << 6) | (((lane >> 4) & 1) << 5) | (((lane >> 5) & 1) << 8); }
constexpr int v_rd_off(int d0, int ks, int half) { return d0 * 512 + ks * 4096 + half * 2048; }
template <int OFF> __device__ __forceinline__ s16x4 tr_read(int vb) {
  s16x4 r; asm volatile("ds_read_b64_tr_b16 %0, %1 offset:%2" : "=&v"(r) : "v"(vb), "i"(OFF) : "memory"); return r;
}
template <int D0> __device__ __forceinline__ void pv_one(f32x16& od, int vb, bf16x8 pa0, bf16x8 pa1, bf16x8 pa2, bf16x8 pa3) {
  const s16x4 l0 = tr_read<v_rd_off(D0, 0, 0)>(vb), h0 = tr_read<v_rd_off(D0, 0, 1)>(vb), l1 = tr_read<v_rd_off(D0, 1, 0)>(vb), h1 = tr_read<v_rd_off(D0, 1, 1)>(vb);
  const s16x4 l2 = tr_read<v_rd_off(D0, 2, 0)>(vb), h2 = tr_read<v_rd_off(D0, 2, 1)>(vb), l3 = tr_read<v_rd_off(D0, 3, 0)>(vb), h3 = tr_read<v_rd_off(D0, 3, 1)>(vb);
  asm volatile("s_waitcnt lgkmcnt(0)" ::: "memory"); SBAR();
#define PK(L, H) (bf16x8){L[0], L[1], L[2], L[3], H[0], H[1], H[2], H[3]}
  od = __builtin_amdgcn_mfma_f32_32x32x16_bf16(pa0, PK(l0, h0), od, 0, 0, 0);
  od = __builtin_amdgcn_mfma_f32_32x32x16_bf16(pa1, PK(l1, h1), od, 0, 0, 0);
  od = __builtin_amdgcn_mfma_f32_32x32x16_bf16(pa2, PK(l2, h2), od, 0, 0, 0);
  od = __builtin_amdgcn_mfma_f32_32x32x16_bf16(pa3, PK(l3, h3), od, 0, 0, 0);
#undef PK
}
__device__ __forceinline__ void pv_d0(f32x16* o, int vb, bf16x8 pa0, bf16x8 pa1, bf16x8 pa2, bf16x8 pa3) {
  pv_one<0>(o[0], vb, pa0, pa1, pa2, pa3); pv_one<1>(o[1], vb, pa0, pa1, pa2, pa3); pv_one<2>(o[2], vb, pa0, pa1, pa2, pa3); pv_one<3>(o[3], vb, pa0, pa1, pa2, pa3);
}
template <bool NA, int SDEPTH, int LDKV>
__device__ __forceinline__ void attn_body(const bf16* __restrict__ Qb, const bf16* __restrict__ Kh, const bf16* __restrict__ Vh,
                                          bf16* __restrict__ Ob, int NT, char* lds, int qrow0, int kr_lo, const float* bl, const int tid, float* __restrict__ ssb) {
  const int wid = tid >> 6, lane = tid & 63, r32 = lane & 31, hi = lane >> 5;
  bf16* V_lds = (bf16*)lds; bf16* K_lds = (bf16*)(lds + 2 * SHM_V);
  float* ws = (float*)(lds + 2 * SHM_V + 2 * SHM_K) + wid * 64; float* li_l = ws; float* al_l = ws + 32;
  float m_reg = -1e30f, l_reg = 0; f32x16 o[4] = {}; bf16x8 qr[8];
  const int qrow = qrow0 + (wid >> 1), qc = 32 * (wid & 1) + r32;
  const int c0 = min(max(qc - 8, 0), 48), r0 = min(max(qrow - 4, 0), 120);
  const bf16* Qw = Qb + (long)(wid * QBLK + r32) * LDQ + hi * 8;
  char* ql = lds + QLDS_OFF + wid * 8192 + lane * 16;
  if constexpr (NA) {
#pragma unroll
    for (int d0 = 0; d0 < 8; ++d0) *reinterpret_cast<bf16x8*>(ql + d0 * 1024) = *reinterpret_cast<const bf16x8*>(Qw + d0 * 16);
  } else {
#pragma unroll
    for (int d0 = 0; d0 < 8; ++d0) qr[d0] = *reinterpret_cast<const bf16x8*>(Qw + d0 * 16);
  }
  const int sr = tid >> 4, sc = (tid & 15) * 8, vst0 = v_st(sr, sc), vst1 = v_st(32 + sr, sc);
  const int vb0 = (int)(uintptr_t)V_lds + v_rd_base(lane);
  struct { bf16x8 vs0, vs1, ks0, ks1; } sr_[SDEPTH];
#define SLOAD(i, k0) do { sr_[i].vs0 = *(const bf16x8*)(&Vh[(long)((k0) + sr) * LDKV + sc]); sr_[i].vs1 = *(const bf16x8*)(&Vh[(long)((k0) + 32 + sr) * LDKV + sc]); \
    sr_[i].ks0 = *(const bf16x8*)(&Kh[(long)((k0) + sr) * LDKV + sc]); sr_[i].ks1 = *(const bf16x8*)(&Kh[(long)((k0) + 32 + sr) * LDKV + sc]); } while (0)
#define SWRITE(b, i) do { *(bf16x8*)((char*)V_lds + (b) * SHM_V + vst0) = sr_[i].vs0;          \
    *(bf16x8*)((char*)V_lds + (b) * SHM_V + vst1) = sr_[i].vs1; int kc = sc * 2;               \
    *(bf16x8*)((char*)K_lds + (b) * SHM_K + KSWZ(sr, kc)) = sr_[i].ks0;                       \
    *(bf16x8*)((char*)K_lds + (b) * SHM_K + KSWZ(32 + sr, kc)) = sr_[i].ks1; } while (0)
#define SWAIT() do { if constexpr (SDEPTH == 2) asm volatile("s_waitcnt vmcnt(4)" ::: "memory"); else asm volatile("s_waitcnt vmcnt(0)" ::: "memory"); } while (0)
#define RESC(a) do { if (__any((a) < 1.f)) { if (hi == 0) al_l[r32] = (a); asm volatile("s_waitcnt lgkmcnt(0)" ::: "memory"); \
    for (int d = 0; d < 4; ++d) for (int r = 0; r < 16; ++r) o[d][r] *= al_l[crow(r, hi)]; } } while (0)
#define NAM(P0, P1, t) do { if constexpr (NA) na_mask(P0, P1, kr_lo + (t), r0, qrow, qc, c0, hi, bl); } while (0)
#define PSM(P0, P1, MN, AL) do { if constexpr (NA) partialSM(P0, P1, m_reg, MN, AL); else { AL = 1.f; _Pragma("unroll") for (int r = 0; r < 16; ++r) P0[r] = __builtin_amdgcn_exp2f(P0[r]); } } while (0)
#define RESCN(a) do { if constexpr (NA) RESC(a); } while (0)
  f32x16 pA0, pA1, pB0, pB1; float mnA, mnB, alA, alB; bf16x8 pa0, pa1, pa2, pa3;
  constexpr int SE = 0, SO = SDEPTH - 1;
  SLOAD(SE, 0); asm volatile("s_waitcnt vmcnt(0)" ::: "memory"); SWRITE(0, SE); __syncthreads();
  qkt<NA>(pA0, pA1, K_lds, qr, ql, r32, hi); NAM(pA0, pA1, 0); PSM(pA0, pA1, mnA, alA);
  SLOAD(SO, KVBLK); if constexpr (SDEPTH == 2) { if (2 < NT) SLOAD(SE, 2 * KVBLK); }
  SWAIT(); SWRITE(1, SO); __syncthreads();
  for (int j = 1; j + 1 < NT; j += 2) {
    SBAR(); qkt<NA>(pB0, pB1, (bf16*)((char*)K_lds + SHM_K), qr, ql, r32, hi); NAM(pB0, pB1, j);
    finishSM(pA0, pA1, alA, l_reg, pa0, pa1, pa2, pa3); SBAR();
    SLOAD(SO, (j + SDEPTH) * KVBLK); SBAR();
    pv_d0(o, vb0, pa0, pa1, pa2, pa3); PSM(pB0, pB1, mnB, alB);
    __syncthreads(); SWAIT(); SWRITE(0, SE);
    RESCN(alB); __syncthreads();
    SBAR(); qkt<NA>(pA0, pA1, K_lds, qr, ql, r32, hi); NAM(pA0, pA1, j + 1);
    finishSM(pB0, pB1, alB, l_reg, pa0, pa1, pa2, pa3); SBAR();
    if (SDEPTH == 1 || j + 3 < NT) SLOAD(SE, (j + 1 + SDEPTH) * KVBLK); SBAR();
    pv_d0(o, vb0 + (int)SHM_V, pa0, pa1, pa2, pa3); PSM(pA0, pA1, mnA, alA);
    __syncthreads(); SWAIT(); SWRITE(1, SO);
    RESCN(alA); __syncthreads();
  }
  SBAR(); qkt<NA>(pB0, pB1, (bf16*)((char*)K_lds + SHM_K), qr, ql, r32, hi); NAM(pB0, pB1, NT - 1);
  finishSM(pA0, pA1, alA, l_reg, pa0, pa1, pa2, pa3); SBAR();
  pv_d0(o, vb0, pa0, pa1, pa2, pa3); PSM(pB0, pB1, mnB, alB);
  __syncthreads(); RESCN(alB);
  finishSM(pB0, pB1, alB, l_reg, pa0, pa1, pa2, pa3); SBAR();
  pv_d0(o, vb0 + (int)SHM_V, pa0, pa1, pa2, pa3);
  if (hi == 0) li_l[r32] = l_reg; asm volatile("s_waitcnt lgkmcnt(0)" ::: "memory");
  float rli[16];
#pragma unroll
  for (int r = 0; r < 16; ++r) rli[r] = __builtin_amdgcn_rcpf(li_l[crow(r, hi)]);
  int tid_e = tid; asm volatile("" : "+v"(tid_e));
  const int lane_e = tid_e & 63, wid_e = tid_e >> 6, r32_e = lane_e & 31, hi_e = lane_e >> 5;
  bf16* Ow = Ob + (long)(wid_e * QBLK) * LDO;
  char* stg = lds + QLDS_OFF + wid_e * 8192;
  char* wb_e = stg + hi_e * 1024 + r32_e * 2 + hi_e * 64;
  char* wb_o = stg + hi_e * 1024 + r32_e * 2 - hi_e * 64;
#pragma unroll
  for (int r = 0; r < 16; ++r) { const int rc = ((r & 3) + 8 * (r >> 2)) * 256;
#pragma unroll
    for (int d0 = 0; d0 < 4; ++d0) { const float v = o[d0][r] * rli[r]; *(bf16*)(((d0 & 1) ? wb_o : wb_e) + rc + d0 * 64) = (bf16)(cvtpk(v, v) & 0xffffu); } }
  asm volatile("s_waitcnt lgkmcnt(0)" ::: "memory");
  const char* rb_e = stg + (lane_e >> 4) * 256 + (lane_e & 15) * 16;
  const char* rb_o = stg + (lane_e >> 4) * 256 + (((lane_e & 15) * 16) ^ 64);
  bf16* gb = Ow + (long)(lane_e >> 4) * LDO + (lane_e & 15) * 8;
#pragma unroll
  for (int i = 0; i < 8; ++i) { const u32x4 w = *(const u32x4*)(((i & 1) ? rb_o : rb_e) + i * 1024); st16_wt(gb + (long)i * 4 * LDO, w);
    float q = sumsq8(w); q += xs(q, 1, lane_e); q += xs(q, 2, lane_e); q += xs(q, 4, lane_e); q += xs(q, 8, lane_e);
    if ((lane_e & 15) == 0) ssb[(size_t)(wid_e * QBLK + (lane_e >> 4) + 4 * i) * 16] = q; }
  asm volatile("s_waitcnt lgkmcnt(0)" ::: "memory");
#undef SLOAD
#undef SWRITE
#undef SWAIT
#undef RESC
#undef NAM
#undef PSM
#undef RESCN
}

template <bool NA, int ROWB>
__device__ __forceinline__ void attn_dma(const bf16* __restrict__ Qb, const bf16* __restrict__ Kh, const bf16* __restrict__ Vh, bf16* __restrict__ Ob, int NT, char* lds, const int tid, float* __restrict__ ssb, int qrow0, int kr_lo, const float* bl) {
  const int wid = tid >> 6, lane = tid & 63, r32 = lane & 31, hi = lane >> 5;
  const int wid_s = __builtin_amdgcn_readfirstlane(wid);
  char* V_lds = lds; char* K_lds = lds + 3 * SHM_V;
  float* li_l = (float*)(lds + 3 * SHM_V + 3 * SHM_K) + wid * 64;
  float* al_l = li_l + 32;
  float m_reg = -1e30f, l_reg = 0; f32x16 o[4] = {}; bf16x8 qr[8];
  const int qrow = qrow0 + (wid >> 1), qc = 32 * (wid & 1) + r32;
  const int c0 = min(max(qc - 8, 0), 48), r0 = min(max(qrow - 4, 0), 120);
  const bf16* Qw = Qb + (long)(wid * QBLK + r32) * LDQ + hi * 8;
#pragma unroll
  for (int d0 = 0; d0 < 8; ++d0) qr[d0] = *reinterpret_cast<const bf16x8*>(Qw + d0 * 16);
  const int vb0 = (int)(uintptr_t)V_lds + v_rd_base(lane);
  auto src_off = [&](int i, unsigned& ko, unsigned& vo) __attribute__((always_inline)) {
    const int b = (wid * 2 + i) * 1024 + lane * 16;
    { const int row = b >> 8, cb = (b & 255) ^ ((row & 7) << 4); ko = (unsigned)(row * ROWB + cb); }
    { const int st = b >> 9, within = b & 511, kk = (st >> 2) * 8 + (within >> 6), c = (st & 3) * 32 + ((within & 63) >> 1);
      const int k = (kk & ~0xC) | ((kk & 4) << 1) | ((kk & 8) >> 1); vo = (unsigned)(k * ROWB + c * 2); }
  };
  unsigned ksrc[2], vsrc[2];
  if constexpr (!NA) { src_off(0, ksrc[0], vsrc[0]); src_off(1, ksrc[1], vsrc[1]); }
#define GAS3 __attribute__((address_space(3)))
#define DMA_TILE(t, b) do { const char* kt_ = (const char*)Kh + (size_t)(t) * (KVBLK * ROWB); const char* vt_ = (const char*)Vh + (size_t)(t) * (KVBLK * ROWB); \
    _Pragma("unroll") for (int i_ = 0; i_ < 2; ++i_) { unsigned ko_, vo_; if constexpr (NA) src_off(i_, ko_, vo_); else { ko_ = ksrc[i_]; vo_ = vsrc[i_]; } \
      __builtin_amdgcn_global_load_lds((const unsigned*)(kt_ + ko_), (GAS3 unsigned*)(K_lds + (b) * SHM_K + (wid_s * 2 + i_) * 1024), 16, 0, 0); \
      __builtin_amdgcn_global_load_lds((const unsigned*)(vt_ + vo_), (GAS3 unsigned*)(V_lds + (b) * SHM_V + (wid_s * 2 + i_) * 1024), 16, 0, 0); } } while (0)
#define VM0() asm volatile("s_waitcnt vmcnt(0)" ::: "memory")
#define RESC(a) do { if (__any((a) < 1.f)) { if (hi == 0) al_l[r32] = (a); asm volatile("s_waitcnt lgkmcnt(0)" ::: "memory"); \
    for (int d = 0; d < 4; ++d) for (int r = 0; r < 16; ++r) o[d][r] *= al_l[crow(r, hi)]; } } while (0)
#define NAM(P0, P1, t) do { if constexpr (NA) na_mask(P0, P1, kr_lo + (t), r0, qrow, qc, c0, hi, bl); } while (0)
#define PSM(P0, P1, MN, AL) do { if constexpr (NA) partialSM(P0, P1, m_reg, MN, AL); else { AL = 1.f; _Pragma("unroll") for (int r = 0; r < 16; ++r) P0[r] = __builtin_amdgcn_exp2f(P0[r]); } } while (0)
#define RESCN(a) do { if constexpr (NA) RESC(a); } while (0)
#define NEXTB(b) ((b) == 2 ? 0 : (b) + 1)
  f32x16 pA0, pA1, pB0, pB1; bf16x8 pa0, pa1, pa2, pa3; float mnA, mnB, alA, alB;
  DMA_TILE(0, 0); DMA_TILE(1, 1); VM0(); __syncthreads();
  qkt<false>(pA0, pA1, (const bf16*)K_lds, qr, nullptr, r32, hi); NAM(pA0, pA1, 0); PSM(pA0, pA1, mnA, alA);
  int bp = 0, bc = 1, bn = 2;
  for (int t = 1; t + 1 < NT; t += 2) {
    DMA_TILE(t + 1, bn);
    SBAR(); qkt<false>(pB0, pB1, (const bf16*)(K_lds + bc * SHM_K), qr, nullptr, r32, hi); NAM(pB0, pB1, t);
    finishSM(pA0, pA1, alA, l_reg, pa0, pa1, pa2, pa3); SBAR();
    pv_d0(o, vb0 + bp * (int)SHM_V, pa0, pa1, pa2, pa3); PSM(pB0, pB1, mnB, alB); RESCN(alB);
    VM0(); __syncthreads();
    bp = bc; bc = bn; bn = NEXTB(bn);
    if (t + 2 < NT) DMA_TILE(t + 2, bn);
    SBAR(); qkt<false>(pA0, pA1, (const bf16*)(K_lds + bc * SHM_K), qr, nullptr, r32, hi); NAM(pA0, pA1, t + 1);
    finishSM(pB0, pB1, alB, l_reg, pa0, pa1, pa2, pa3); SBAR();
    pv_d0(o, vb0 + bp * (int)SHM_V, pa0, pa1, pa2, pa3); PSM(pA0, pA1, mnA, alA); RESCN(alA);
    VM0(); __syncthreads();
    bp = bc; bc = bn; bn = NEXTB(bn);
  }
  SBAR(); qkt<false>(pB0, pB1, (const bf16*)(K_lds + bc * SHM_K), qr, nullptr, r32, hi); NAM(pB0, pB1, NT - 1);
  finishSM(pA0, pA1, alA, l_reg, pa0, pa1, pa2, pa3); SBAR();
  pv_d0(o, vb0 + bp * (int)SHM_V, pa0, pa1, pa2, pa3); PSM(pB0, pB1, mnB, alB); RESCN(alB);
  finishSM(pB0, pB1, alB, l_reg, pa0, pa1, pa2, pa3); SBAR();
  pv_d0(o, vb0 + bc * (int)SHM_V, pa0, pa1, pa2, pa3);
  if (hi == 0) li_l[r32] = l_reg; asm volatile("s_waitcnt lgkmcnt(0)" ::: "memory");
  float rli[16];
#pragma unroll
  for (int r = 0; r < 16; ++r) rli[r] = __builtin_amdgcn_rcpf(li_l[crow(r, hi)]);
  bf16* Ow = Ob + (long)(wid * QBLK) * LDO;
#undef DMA_TILE
#undef VM0
#undef RESC
#undef NAM
#undef PSM
#undef RESCN
#undef NEXTB
#undef GAS3
  int tid_e = tid; asm volatile("" : "+v"(tid_e));
  const int lane_e = tid_e & 63, wid_e = tid_e >> 6, r32_e = lane_e & 31, hi_e = lane_e >> 5;
  char* sg = lds + 100 * 1024 + wid_e * 4096;
#pragma unroll
  for (int half = 0; half < 2; ++half) {
    char* wb_e = sg + hi_e * 1024 + r32_e * 2 + hi_e * 64;
    char* wb_o = sg + hi_e * 1024 + r32_e * 2 - hi_e * 64;
#pragma unroll
    for (int rr = 0; rr < 8; ++rr) { const int r = half * 8 + rr; const int rc = ((rr & 3) + 8 * (rr >> 2)) * 256;
#pragma unroll
      for (int d0 = 0; d0 < 4; ++d0) { const float v = o[d0][r] * rli[r]; *(bf16*)(((d0 & 1) ? wb_o : wb_e) + rc + d0 * 64) = (bf16)(cvtpk(v, v) & 0xffffu); } }
    asm volatile("s_waitcnt lgkmcnt(0)" ::: "memory");
    const char* rb_e = sg + (lane_e >> 4) * 256 + (lane_e & 15) * 16;
    const char* rb_o = sg + (lane_e >> 4) * 256 + (((lane_e & 15) * 16) ^ 64);
    bf16* gb = Ow + (long)(half * 16 + (lane_e >> 4)) * LDO + (lane_e & 15) * 8;
#pragma unroll
    for (int i = 0; i < 4; ++i) { const u32x4 w = *(const u32x4*)(((i & 1) ? rb_o : rb_e) + i * 1024); st16_wt(gb + (long)i * 4 * LDO, w);
      float q = sumsq8(w); q += xs(q, 1, lane_e); q += xs(q, 2, lane_e); q += xs(q, 4, lane_e); q += xs(q, 8, lane_e);
      if ((lane_e & 15) == 0) ssb[(size_t)(wid_e * QBLK + half * 16 + (lane_e >> 4) + 4 * i) * 16] = q; }
    asm volatile("s_waitcnt lgkmcnt(0)" ::: "memory");
  }
}
#undef SBAR
#undef KSWZ
}
#define LAS __attribute__((address_space(3)))
typedef unsigned short bf16_t;
typedef float f32x4 __attribute__((ext_vector_type(4)));
typedef unsigned u32x4 __attribute__((ext_vector_type(4)));
typedef unsigned u32x2 __attribute__((ext_vector_type(2)));
#ifndef PHMASK
#define PHMASK 255
#endif
#ifndef PROBE_DUP
#define PROBE_DUP 0
#endif
#ifndef FUSE_LN
#define FUSE_LN 1
#endif
#ifndef GQA_SDEPTH
#define GQA_SDEPTH 1
#endif
#ifndef MK_PER_PHASE_LAUNCH
#define MK_PER_PHASE_LAUNCH 0
#endif
constexpr int SEQ = 8192, DM = 2048, DFF = 5632, DIN = 4608, NLAYER = 2, NGU = 2 * DFF;
constexpr int NPHASE = 1 + 12 * NLAYER;
constexpr float ALPHA = 1.4142135623730951f, LN_EPS = 1e-5f, RMS_EPS = 1e-6f;
constexpr int LDS_BYTES = 147456;
constexpr size_t SZ_WGU = (size_t)NGU * DM * 2, SZ_WD = (size_t)DM * DFF * 2, SZ_WIN = (size_t)DIN * DM * 2, SZ_WOUT = (size_t)DM * DM * 2;
constexpr size_t OFF_WGU = 0, OFF_WD = OFF_WGU + 4 * SZ_WGU, OFF_WIN = OFF_WD + 4 * SZ_WD, OFF_WOUT = OFF_WIN + 2 * SZ_WIN;
constexpr size_t OFF_XF = OFF_WOUT + 2 * SZ_WOUT, OFF_XB = OFF_XF + (size_t)SEQ * DM * 4, OFF_HID = OFF_XB + (size_t)SEQ * DM * 2;
constexpr size_t OFF_H = OFF_HID + (size_t)SEQ * DFF * 2, OFF_OB = OFF_H + (size_t)SEQ * DIN * 2, WS_END = OFF_OB + (size_t)SEQ * DM * 2;
constexpr size_t OFF_BAR = WS_END, BAR_BYTES = 262144;
constexpr size_t OFF_CNT = OFF_BAR + 16384, OFF_XBUF = OFF_BAR + BAR_BYTES, OFF_SS = OFF_XBUF + (size_t)SEQ * 8 * 8, OFF_KC = OFF_SS + (size_t)SEQ * 16 * 4,     WS_TOTAL = OFF_KC + (size_t)4 * SEQ * 128 * 2;
constexpr int MISC_OFF = LDS_BYTES - 64;
constexpr size_t OFF_O = OFF_HID;
static_assert((size_t)SEQ * DM * 4 <= (size_t)SEQ * DFF * 2, "O overlay fits");

#define XB_TMO      128
#define XB_XCNT(j)  (256  + 64 * (j))
#define XB_XSUB(j)  (1280 + 64 * (j))
#define XB_XGEN(j)  (2304 + 64 * (j))
#define XB_TOP      3328
#define XB_TOPGEN   3392
#define XCD_BAR_WORDS 3456
#define XB_SPIN_CAP (1u << 18)

__device__ __forceinline__ unsigned xb_ld(unsigned* p)              { return __hip_atomic_load(p, __ATOMIC_RELAXED, __HIP_MEMORY_SCOPE_AGENT); }
__device__ __forceinline__ unsigned xb_add(unsigned* p, unsigned v) { return __hip_atomic_fetch_add(p, v, __ATOMIC_RELAXED, __HIP_MEMORY_SCOPE_AGENT); }
__device__ __forceinline__ unsigned xb_xcc_id() { return (unsigned)__builtin_amdgcn_s_getreg((3 << 11) | 20) & 0xFu; }
#define XB_SPIN(cond, bar) do { unsigned _sp = 0; while (cond) { __builtin_amdgcn_s_sleep(1); \
    if ((++_sp & 255u) == 0u) { if (xb_ld(&(bar)[XB_TMO])) break; if (_sp > XB_SPIN_CAP) { atomicAdd(&(bar)[XB_TMO], 1u); break; } } } } while (0)

struct XcdBarrier {
    unsigned* bar; unsigned x;
    volatile LAS unsigned* st;
};

__device__ __forceinline__ XcdBarrier xcd_barrier_post(unsigned* bar, volatile LAS unsigned* st) {
    XcdBarrier b; b.bar = bar; b.x = xb_xcc_id(); b.st = st;
    if (threadIdx.x == 0) (void)xb_add(&bar[XB_XCNT(b.x)], 1u);
    return b;
}
__device__ __forceinline__ void xcd_barrier_complete(unsigned* bar, unsigned x, unsigned& nloc, unsigned& nx) {
    const unsigned G = gridDim.x * gridDim.y * gridDim.z;
    unsigned sum, cnt, mine, sp = 0u;
    for (;;) {
        sum = 0u; cnt = 0u; mine = 0u;
#pragma unroll
        for (unsigned j = 0; j < 16; ++j) { const unsigned c = xb_ld(&bar[XB_XCNT(j)]); sum += c; cnt += (c > 0u) ? 1u : 0u; mine = (j == x) ? c : mine; }
        if (sum == G) break;
        __builtin_amdgcn_s_sleep(1);
        if ((++sp & 255u) == 0u) { if (xb_ld(&bar[XB_TMO])) break; if (sp > XB_SPIN_CAP) { atomicAdd(&bar[XB_TMO], 1u); break; } }
    }
    nloc = mine > 0u ? mine : 1u; nx = cnt > 0u ? cnt : 1u;
}

__device__ __forceinline__ void xcd_barrier(const XcdBarrier& b) {
    asm volatile("s_waitcnt vmcnt(0)" ::: "memory");
    __syncthreads();
    if (threadIdx.x == 0) {
        unsigned* bar = b.bar;
        __builtin_amdgcn_s_waitcnt(0);
        unsigned nloc = b.st[0], nx = b.st[1];
        if (nloc == 0u) { xcd_barrier_complete(bar, b.x, nloc, nx); b.st[0] = nloc; b.st[1] = nx; }
        const unsigned old = xb_add(&bar[XB_XSUB(b.x)], 1u);
        const unsigned gen = old / nloc;
        if (old + 1u == (gen + 1u) * nloc) {
            __builtin_amdgcn_fence(__ATOMIC_RELEASE, "agent");
            asm volatile("s_waitcnt vmcnt(0)" ::: "memory");
            const unsigned og = xb_add(&bar[XB_TOP], 1u);
            const unsigned tg = og / nx;
            if (og + 1u == (tg + 1u) * nx) xb_add(&bar[XB_TOPGEN], 1u);
            else XB_SPIN(xb_ld(&bar[XB_TOPGEN]) == tg, bar);
            __builtin_amdgcn_fence(__ATOMIC_ACQUIRE, "agent");
            xb_add(&bar[XB_XGEN(b.x)], 1u);
            asm volatile("s_waitcnt vmcnt(0)" ::: "memory");
        } else {
            XB_SPIN(xb_ld(&bar[XB_XGEN(b.x)]) == gen, bar);
            __builtin_amdgcn_fence(__ATOMIC_ACQUIRE, "agent");
            asm volatile("s_waitcnt vmcnt(0)" ::: "memory");
        }
    }
    __syncthreads();
}

__device__ __forceinline__ unsigned pk2(float lo, float hi) { unsigned r; asm volatile("v_cvt_pk_bf16_f32 %0, %1, %2" : "=v"(r) : "v"(lo), "v"(hi)); return r; }
__device__ __forceinline__ float wave_sum(float v, int lane) {
#pragma unroll
    for (int o = 1; o < 64; o <<= 1) v += pg8::xshfl(v, o, lane);
    return v;
}
__device__ __forceinline__ void transpose_item(const float* __restrict__ W, int K, int N, bf16_t* __restrict__ WT, int drow0, LAS float* scr, int k0, int n0, int lane, const float* __restrict__ gk) {
    const float* src = W + (size_t)k0 * N + n0 + lane;
#pragma unroll
    for (int hb = 0; hb < 1; ++hb) {
        float v[64];
#pragma unroll
        for (int i = 0; i < 64; ++i) v[i] = __builtin_nontemporal_load(src + (size_t)(hb * 64 + i) * N);
        if (gk) {
#pragma unroll
            for (int i = 0; i < 64; ++i) v[i] *= gk[k0 + hb * 64 + i];
        }
#pragma unroll
        for (int i = 0; i < 64; ++i) scr[(hb * 64 + i) * 65 + lane] = v[i];
    }
    asm volatile("s_waitcnt lgkmcnt(0)" ::: "memory");
    const int c = lane & 7;
#pragma unroll
    for (int j = 0; j < 8; ++j) { const int n = (lane >> 3) + 8 * j; const LAS float* s = scr + (8 * c) * 65 + n;
        u32x4 o; o.x = pk2(s[0 * 65], s[1 * 65]); o.y = pk2(s[2 * 65], s[3 * 65]); o.z = pk2(s[4 * 65], s[5 * 65]); o.w = pk2(s[6 * 65], s[7 * 65]);
        *(u32x4*)(WT + (size_t)(drow0 + n) * K + k0 + 8 * c) = o; }
    asm volatile("s_waitcnt lgkmcnt(0)" ::: "memory");
}
__device__ __forceinline__ void transpose_matrix(const float* W, int K, int N, bf16_t* WT, int mode, LAS float* scr, int gw, int NGW, int lane, const float* gA, const float* gB, int it_lo, int it_hi) {
    const int nblk = N / 64, w8 = gw & 7;
    for (int j = (it_lo >> 3) + (gw >> 3); j < (it_hi >> 3); j += (NGW >> 3)) {
        const int kb = (j / nblk) * 8 + w8, nb = j % nblk, n0 = nb * 64;
        int drow0 = n0;
        if (mode) { const int up = n0 >= DFF, j = n0 - up * DFF; drow0 = 256 * (j / 128) + (j % 128) + up * 128; }
        transpose_item(W, K, N, WT, drow0, scr, kb * 64, n0, lane, gA ? (kb * 64 < 1024 ? gA : gB - 1024) : nullptr);
    }
}
constexpr int CQ1 = 5400, CQ2 = 14096, CQ3 = 20400, CQ4 = 25600, CQ5 = 32304, CQ6 = 34816;
static_assert(CQ1 % 8 == 0 && CQ2 % 8 == 0 && CQ3 % 8 == 0 && CQ4 % 8 == 0 && CQ5 % 8 == 0 && CQ6 % 8 == 0, "slot boundaries in units of 8 items");
constexpr int QN_D = (DFF / 64) * (DM / 64), QN_GU = (DM / 64) * (NGU / 64), QN_IN = (DM / 64) * (DIN / 64), QN_OUT = (DM / 64) * (DM / 64);
static_assert(3 * QN_GU + 4 * QN_D + 2 * QN_IN + 2 * QN_OUT == CQ6, "conversion queue length");
static_assert(CQ1 >= QN_D + QN_IN && CQ2 >= QN_D + QN_IN + QN_OUT + QN_GU && CQ3 >= 2 * QN_D + QN_IN + QN_OUT + 2 * QN_GU && CQ4 >= 3 * QN_D + 2 * QN_IN + QN_OUT + 2 * QN_GU && CQ5 >= 3 * QN_D + 2 * QN_IN + 2 * QN_OUT + 3 * QN_GU, "each matrix is converted before the phase that first reads it");
template <class ArgsP>
__device__ __forceinline__ void convert_queue(ArgsP ap, unsigned char* ws, int q_lo, int q_hi, LAS float* scr, int gw, int NGW, int lane) {
    int off = 0;
#pragma unroll 1
    for (int qi = 0; qi < 11; ++qi) {
        const int l = qi >= 5, f = (qi == 3 || qi == 4 || qi == 9 || qi == 10);
        const bool isgu = (qi == 3 || qi == 5 || qi == 9), isin = (qi == 1 || qi == 7), isout = (qi == 2 || qi == 8);
        const int n = isgu ? QN_GU : isin ? QN_IN : isout ? QN_OUT : QN_D;
        const int lo = max(q_lo - off, 0), hi = min(q_hi - off, n);
        if (lo < hi) {
            if (isgu) transpose_matrix((f ? ap->in[14] : ap->in[1]) + (size_t)l * DM * NGU, DM, NGU, (bf16_t*)(ws + OFF_WGU + (size_t)(l * 2 + f) * SZ_WGU), 1, scr, gw, NGW, lane, nullptr, nullptr, lo, hi);
            else if (isin) transpose_matrix(ap->in[5] + (size_t)l * DM * DIN, DM, DIN, (bf16_t*)(ws + OFF_WIN + (size_t)l * SZ_WIN), 0, scr, gw, NGW, lane, nullptr, nullptr, lo, hi);
            else if (isout) transpose_matrix(ap->in[11] + (size_t)l * DM * DM, DM, DM, (bf16_t*)(ws + OFF_WOUT + (size_t)l * SZ_WOUT), 0, scr, gw, NGW, lane, ap->in[9] + (size_t)l * 1024, ap->in[10] + (size_t)l * 1024, lo, hi);
            else transpose_matrix((f ? ap->in[15] : ap->in[2]) + (size_t)l * DFF * DM, DFF, DM, (bf16_t*)(ws + OFF_WD + (size_t)(l * 2 + f) * SZ_WD), 0, scr, gw, NGW, lane, nullptr, nullptr, lo, hi);
        }
        off += n;
    }
}
__device__ __forceinline__ void group_stats_rows(const bf16_t* OB, float* RS, int gw, int NGW, int lane) {
    for (int row0 = gw; row0 < SEQ; row0 += 4 * NGW) {
        u32x4 w[4][4];
#pragma unroll
        for (int k = 0; k < 4; ++k)
#pragma unroll
            for (int j = 0; j < 4; ++j) w[k][j] = ((const u32x4*)(OB + (size_t)(row0 + k * NGW) * DM) + lane)[64 * j];
#pragma unroll
        for (int k = 0; k < 4; ++k) {
            float sa = 0.f, sb = 0.f;
#pragma unroll
            for (int j = 0; j < 4; ++j) { float q = 0.f;
#pragma unroll
                for (int e = 0; e < 4; ++e) { const float lo = __uint_as_float(w[k][j][e] << 16), hi = __uint_as_float(w[k][j][e] & 0xffff0000u); q += lo * lo + hi * hi; }
                if (j < 2) sa += q; else sb += q; }
            const float ra = 1.f / sqrtf(wave_sum(sa, lane) * (1.f / 1024.f) + RMS_EPS), rb = 1.f / sqrtf(wave_sum(sb, lane) * (1.f / 1024.f) + RMS_EPS);
            if (lane == 0) { RS[2 * (row0 + k * NGW)] = ra / rb; RS[2 * (row0 + k * NGW) + 1] = rb; }
        }
    }
}
__device__ __forceinline__ void qk_prep(bf16_t* H, bf16_t* KC, bf16_t* VC, const float* __restrict__ qg, const float* __restrict__ kg, int gw, int NGW, int lane) {
    const int q16 = lane & 15, half = q16 >> 3, i0 = 8 * (q16 & 3); const bool first = (q16 & 7) < 4;
    float invf[8];
#pragma unroll
    for (int e = 0; e < 8; ++e) invf[e] = __builtin_amdgcn_exp2f(-(float)(i0 + e) * (13.287712379549449f / 32.f));
    for (int t0 = gw; t0 < SEQ; t0 += 4 * NGW) {
      u32x4 wq[4][3];
#pragma unroll
      for (int kk = 0; kk < 4; ++kk)
#pragma unroll
        for (int k = 0; k < 3; ++k) wq[kk][k] = ((const u32x4*)(H + (size_t)(t0 + kk * NGW) * DIN + 3072))[lane + 64 * k];
#pragma unroll
      for (int kk = 0; kk < 4; ++kk) {
        const int t = t0 + kk * NGW;
        u32x4* src = (u32x4*)(H + (size_t)t * DIN + 3072);
        const float pos = (float)(half ? (t & 63) : (t >> 6));
        u32x4 w[3];
#pragma unroll
        for (int k = 0; k < 3; ++k) w[k] = wq[kk][k];
#pragma unroll
        for (int k = 0; k < 3; ++k) {
            float x[8];
#pragma unroll
            for (int e = 0; e < 4; ++e) { x[2 * e] = __uint_as_float(w[k][e] << 16); x[2 * e + 1] = __uint_as_float(w[k][e] & 0xffff0000u); }
            float ss = 0.f;
#pragma unroll
            for (int e = 0; e < 8; ++e) ss += x[e] * x[e];
            ss += pg8::xshfl(ss, 1, lane); ss += pg8::xshfl(ss, 2, lane); ss += pg8::xshfl(ss, 4, lane); ss += pg8::xshfl(ss, 8, lane);
            const float rstd = 1.f / sqrtf(ss * (1.f / 128.f) + RMS_EPS);
            const float* g = (k < 2 ? qg : kg) + 8 * q16;
            float o[8];
#pragma unroll
            for (int e = 0; e < 8; ++e) { const float y = x[e] * rstd * g[e], yp = pg8::xshfl(y, 4, lane); const float ang = pos * invf[e], cs = __cosf(ang), sn = __sinf(ang);
                o[e] = first ? y * cs - yp * sn : y * cs + yp * sn; if (k < 2) o[e] *= (att::SCALE * 1.4426950408889634f); }
            u32x4 r; r.x = pk2(o[0], o[1]); r.y = pk2(o[2], o[3]); r.z = pk2(o[4], o[5]); r.w = pk2(o[6], o[7]);
            if (k < 2) src[lane + 64 * k] = r;
            else if (lane < 32) *(u32x4*)(KC + ((size_t)(lane >> 4) * SEQ + t) * 128 + 8 * q16) = r;
            else *(u32x4*)(VC + ((size_t)((lane - 32) >> 4) * SEQ + t) * 128 + 8 * q16) = w[2];
        }
      }
    }
}

struct Args { const float* in[18]; float* out; unsigned char* ws; int ph_lo, ph_hi; };
__global__ void __launch_bounds__(512, 2) fwd_megakernel(Args a) {
    extern __shared__ __attribute__((aligned(16))) unsigned char lds[];
    cg::grid_group grid = cg::this_grid();
    const int ph_lo = a.ph_lo, ph_hi = a.ph_hi;
    if (threadIdx.x < 16) ((LAS unsigned*)((LAS unsigned char*)lds + MISC_OFF))[threadIdx.x] = 0u;
    __syncthreads();
    const XcdBarrier xbar = xcd_barrier_post((unsigned*)(a.ws + OFF_BAR), (volatile LAS unsigned*)((LAS unsigned char*)lds + MISC_OFF));
    const int wave_s = __builtin_amdgcn_readfirstlane((int)threadIdx.x >> 6);
    for (int ph = ph_lo; ph < ph_hi; ++ph) {
        const int kind_ = ph == 0 ? -1 : (ph - 1) % 12;
        if (kind_ == 2 || kind_ == 8 || kind_ == 11 || kind_ == 6) continue;
        if (ph > ph_lo) { if (ph == ph_lo + 1 && ph_lo != 0) grid.sync(); else xcd_barrier(xbar); if (PROBE_DUP & 32) xcd_barrier(xbar); }
        const int nrep = ((kind_ == -1 && (PROBE_DUP & 1)) || ((kind_ == 0 || kind_ == 9) && (PROBE_DUP & 2)) || (kind_ == 3 && (PROBE_DUP & 4)) || (kind_ == 5 && (PROBE_DUP & 8)) || (kind_ == 6 && (PROBE_DUP & 16))) ? 2 : 1;
        for (int rep = 0; rep < nrep; ++rep) {
        const __attribute__((address_space(4))) Args* ap = (const __attribute__((address_space(4))) Args*)__builtin_amdgcn_kernarg_segment_ptr();
        asm volatile("" : "+s"(ap) :: "memory");
#define a (*ap)
        int lane_; asm volatile("v_mbcnt_lo_u32_b32 %0, -1, 0\n\tv_mbcnt_hi_u32_b32 %0, -1, %0" : "=v"(lane_));
        int tid = wave_s * 64 + lane_; asm volatile("" : "+v"(tid));
        const int lane = tid & 63, wave = __builtin_amdgcn_readfirstlane(tid >> 6);
        const int G = gridDim.x, gw = blockIdx.x * 8 + wave, NGW = G * 8;
        unsigned char* ws = a.ws;
        bf16_t* const XB = (bf16_t*)(ws + OFF_XB); float* const XF = (float*)(ws + OFF_XF); bf16_t* const HID = (bf16_t*)(ws + OFF_HID);
        bf16_t* const Hb = (bf16_t*)(ws + OFF_H); bf16_t* const KC = (bf16_t*)(ws + OFF_KC); bf16_t* const VC = KC + (size_t)2 * SEQ * 128; float* const Of = (float*)(ws + OFF_O); bf16_t* const OB = (bf16_t*)(ws + OFF_OB);
        if (ph == 0 && (PHMASK & 1)) {
            LAS float* scr = (LAS float*)((LAS unsigned char*)lds + wave * 16640);
            transpose_matrix(a.in[1], DM, NGU, (bf16_t*)(ws + OFF_WGU), 1, scr, gw, NGW, lane, nullptr, nullptr, 0, QN_GU);
            const f32x4* xs = (const f32x4*)a.in[0]; u32x2* xd = (u32x2*)XB;
            for (int p0 = blockIdx.x * 512 + tid; p0 < SEQ * DM / 8; p0 += G * 512 * 8) {
                f32x4 v[8][2];
#pragma unroll
                for (int j = 0; j < 8; ++j) { v[j][0] = __builtin_nontemporal_load(xs + 2 * (p0 + j * G * 512)); v[j][1] = __builtin_nontemporal_load(xs + 2 * (p0 + j * G * 512) + 1); }
#pragma unroll
                for (int j = 0; j < 8; ++j) { u32x4 w; w.x = pk2(v[j][0].x, v[j][0].y); w.y = pk2(v[j][0].z, v[j][0].w); w.z = pk2(v[j][1].x, v[j][1].y); w.w = pk2(v[j][1].z, v[j][1].w);
                    ((u32x4*)xd)[p0 + j * G * 512] = w; }
            }
            __syncthreads();
            continue;
        }
        const int l = (ph - 1) / 12, kind = (ph - 1) % 12;
        if ((kind == 0 || kind == 9) && (PHMASK & 2)) {
            const int f = kind == 9;
            pg8::Gemm g{XB, (const bf16_t*)(ws + OFF_WGU + (size_t)(l * 2 + f) * SZ_WGU), SEQ, NGU, DM};
            pg8::TailOrder S; S.init(SEQ, NGU, G, (int)blockIdx.x, 1);
            pg8::EpiSwiGLU E{HID, DFF};
            pg8::gemm_phase<pg8::EpiSwiGLU, pg8::TailOrder, true, true>((LAS unsigned char*)lds, g, S, E, tid);
            { const int idle0 = (SEQ / 256) * (NGU / 256) % G;
              const int q_lo = l == 0 ? (f ? CQ2 : 0) : (f ? CQ5 : CQ3), q_hi = l == 0 ? (f ? CQ3 : CQ1) : (f ? CQ6 : CQ4);
              if (idle0 > 0 && (int)blockIdx.x >= idle0) convert_queue(ap, ws, q_lo, q_hi, (LAS float*)((LAS unsigned char*)lds + wave * 16640), ((int)blockIdx.x - idle0) * 8 + wave, (G - idle0) * 8, lane); }
        } else if ((kind == 1 || kind == 10 || kind == 7) && (PHMASK & 4)) {
            const int f = kind == 10;
            const bool wo = kind == 7;
            pg8::Gemm g{wo ? OB : HID, (const bf16_t*)(wo ? ws + OFF_WOUT + (size_t)l * SZ_WOUT : ws + OFF_WD + (size_t)(l * 2 + f) * SZ_WD), SEQ, DM, wo ? DM : DFF};
            pg8::StaticOrder S; S.init(SEQ, DM, G, (int)blockIdx.x);
            {
                const int gi = kind == 1 ? 3 : kind == 7 ? 12 : 16;
                float* dst = (kind == 10 && l == NLAYER - 1) ? a.out : (float*)nullptr;
                pg8::PanelStats8 st{(unsigned long long*)(ws + OFF_XBUF), (unsigned*)(ws + OFF_CNT) + (size_t)ph * 2048, LN_EPS};
                LAS float* rsl = (LAS float*)((LAS unsigned char*)lds + 132 * 1024);
                if (wo) {
                    pg8::Unit u0; S.next(0, u0);
                    const f32x4* sp = (const f32x4*)((const float*)(ws + OFF_SS) + (size_t)(u0.pm * 256 + (tid >> 1)) * 16 + (tid & 1) * 8);
                    const f32x4 s0 = sp[0], s1 = sp[1];
                    const float ssum = ((s0.x + s0.y) + (s0.z + s0.w)) + ((s1.x + s1.y) + (s1.z + s1.w));
                    const float rme = 1.f / sqrtf(ssum * (1.f / 1024.f) + RMS_EPS), rot = pg8::xshfl(rme, 1, lane);
                    if (!(tid & 1)) { rsl[2 * (tid >> 1)] = rme / rot; rsl[2 * (tid >> 1) + 1] = rot; }
                    __syncthreads();
                }
                pg8::EpiResidLn E{XB, dst, XB, DM, ALPHA, wo ? 1.0f : 0.5f, a.in[gi] + (size_t)l * DM, a.in[gi + 1] + (size_t)l * DM, st, rsl, wo ? 1 : 0};
                pg8::gemm_phase<pg8::EpiResidLn, pg8::StaticOrder, false, true>((LAS unsigned char*)lds, g, S, E, tid);
            }
        } else if (kind == 3 && (PHMASK & 16)) {
            pg8::Gemm g{XB, (const bf16_t*)(ws + OFF_WIN + (size_t)l * SZ_WIN), SEQ, DIN, DM};
            pg8::TailOrder S; S.init(SEQ, DIN, G, (int)blockIdx.x, 1);
            pg8::EpiBf16<0> E{Hb, DIN, nullptr, 0, 0, 1.f};
            pg8::gemm_phase<pg8::EpiBf16<0>, pg8::TailOrder, true, true>((LAS unsigned char*)lds, g, S, E, tid);
            { const int idle0 = (SEQ / 256) * (DIN / 256) % G;
              const int q_lo = l == 0 ? CQ1 : CQ4, q_hi = l == 0 ? CQ2 : CQ5;
              if (idle0 > 0 && (int)blockIdx.x >= idle0) convert_queue(ap, ws, q_lo, q_hi, (LAS float*)((LAS unsigned char*)lds + wave * 16640), ((int)blockIdx.x - idle0) * 8 + wave, (G - idle0) * 8, lane); }
        } else if (kind == 4 && (PHMASK & 32)) {
            qk_prep(Hb, KC, VC, a.in[7] + l * 128, a.in[8] + l * 128, gw, NGW, lane);
            float* bl = (float*)((char*)lds + 98 * 1024);
            for (int nr = 0; nr < ((PROBE_DUP & 64) ? 2 : 1); ++nr)
            for (int u = blockIdx.x; u < 256; u += G) {
                const int h = u & 7, blk = u >> 3;
                __syncthreads();
                for (int i = tid; i < 465; i += 512) bl[i] = a.in[6][(size_t)(l * 8 + h) * 465 + i] * (1.0f / att::SCALE);
                const int kr_lo = max(0, 4 * blk - 4), NT = min(12, 128 - kr_lo);
                att::attn_dma<true, 9216>(Hb + (size_t)(blk * 256) * DIN + h * 128, Hb + (size_t)(kr_lo * 64) * DIN + 1024 + h * 128, Hb + (size_t)(kr_lo * 64) * DIN + 2048 + h * 128,
                                          OB + (size_t)(blk * 256) * DM + h * 128, NT, (char*)lds, tid, (float*)(ws + OFF_SS) + (size_t)(blk * 256) * 16 + h, 4 * blk, kr_lo, bl);
            }
        } else if (kind == 5 && (PHMASK & 64)) {
            for (int u = blockIdx.x; u < 256; u += G) {
                const int h = u & 7, qb = u >> 3;
                __syncthreads();
                att::attn_dma<false, 256>(Hb + (size_t)(qb * 256) * DIN + 3072 + h * 128, KC + (size_t)(h >> 2) * SEQ * 128, VC + (size_t)(h >> 2) * SEQ * 128,
                                OB + (size_t)(qb * 256) * DM + 1024 + h * 128, 128, (char*)lds, tid, (float*)(ws + OFF_SS) + (size_t)(qb * 256) * 16 + 8 + h, 0, 0, nullptr);
            }
        } else if (PHMASK & 128) {
            ;
        }
        }
#undef a
    }
}

extern "C" void kernel_launch(void* const* d_in, const int* in_sizes, int n_in, void* d_out, int out_size, void* d_ws, size_t ws_size, hipStream_t stream) {
    static int grid_blocks = 0;
    if (grid_blocks == 0) {
        if (n_in != 18 || in_sizes[0] != SEQ * DM || out_size != SEQ * DM || ws_size < WS_TOTAL) {
            fprintf(stderr, "kernel_launch: unexpected shapes: n_in %d in0 %d out %d ws %zu (need %zu)\n", n_in, n_in > 0 ? in_sizes[0] : -1, out_size, ws_size, (size_t)WS_TOTAL); grid_blocks = -1; return; }
        int dev = 0, cus = 0, per_cu = 0;
        hipGetDevice(&dev);
        hipDeviceGetAttribute(&cus, hipDeviceAttributeMultiprocessorCount, dev);
        if (hipFuncSetAttribute((const void*)fwd_megakernel, hipFuncAttributeMaxDynamicSharedMemorySize, LDS_BYTES) != hipSuccess) { fprintf(stderr, "kernel_launch: hipFuncSetAttribute failed\n"); grid_blocks = -1; return; }
        if (hipOccupancyMaxActiveBlocksPerMultiprocessor(&per_cu, (const void*)fwd_megakernel, 512, LDS_BYTES) != hipSuccess || per_cu < 1) { fprintf(stderr, "kernel_launch: occupancy query gave %d\n", per_cu); per_cu = 1; }
        (void)hipGetLastError();
        grid_blocks = cus * per_cu;
        if (grid_blocks != 256) { fprintf(stderr, "kernel_launch: this kernel needs exactly 256 co-resident workgroups (got %d x %d)\n", cus, per_cu); grid_blocks = -1; return; }
    }
    if (grid_blocks < 0) return;
    if (hipMemsetAsync((char*)d_ws + OFF_BAR, 0, BAR_BYTES, stream) != hipSuccess) { fprintf(stderr, "kernel_launch: memset failed\n"); return; }
    Args a{};
    for (int i = 0; i < 18; ++i) a.in[i] = (const float*)d_in[i];
    a.out = (float*)d_out; a.ws = (unsigned char*)d_ws;
#if MK_PER_PHASE_LAUNCH
    for (int p = 0; p < NPHASE; ++p) { a.ph_lo = p; a.ph_hi = p + 1; hipLaunchKernelGGL(fwd_megakernel, dim3(grid_blocks), dim3(512), LDS_BYTES, stream, a); }
#else
    a.ph_lo = 0; a.ph_hi = NPHASE;
    void* args[] = {&a};
    hipError_t e = hipLaunchCooperativeKernel((void*)fwd_megakernel, dim3(grid_blocks), dim3(512), args, LDS_BYTES, stream);
    if (e != hipSuccess) fprintf(stderr, "cooperative launch failed: %s (grid %d)\n", hipGetErrorString(e), grid_blocks);
#endif
}
```
